# Optimizing an MI355X kernel written in HIP

```python
import math
import jax, jax.numpy as jnp
from jax import lax
import numpy as np

D_MODEL = 1024
BATCH = 8
SEQ = 2048
DEPTH = 1

MEM_LEN = 256
NSA_HEADS = 8
NSA_KV_GROUPS = 2
NSA_HPG = NSA_HEADS // NSA_KV_GROUPS
HEAD_DIM = 64
CMP_LEN = 32
CMP_STRIDE = 16
CMP_HIDDEN = 256
SLC_BLOCK = 64
SLC_TOPN = 8
WINDOW = 512
Q_BLOCK = 128
N_BAND = WINDOW // Q_BLOCK
ROPE_THETA = 500000.0
ROPE_DIM = HEAD_DIM // 4
SGU_CHUNK = 128
SGU_GROUPS = 8
SGU_WIDTH = 512
SGU_GROUP_DIM = SGU_WIDTH // SGU_GROUPS
MEM_HEADS = 4
MEM_HEAD_DIM = 128
MEM_WIDTH = MEM_HEADS * MEM_HEAD_DIM
N_BRANCH = 3
N_NSA_BRANCH = 3
N_GROUPS = 4
EXPERTS_PER_GROUP = 8
EXPERT_FF = 256
TOP_K = 2
DN_ALPHA = (2.0 * DEPTH) ** 0.25
DN_BETA = (8.0 * DEPTH) ** -0.25
LN_EPS = 1e-5
NEG = -1e30

Q_W = NSA_HEADS * HEAD_DIM
KV_W = NSA_KV_GROUPS * HEAD_DIM
COL_SIZES = [Q_W, KV_W, KV_W, KV_W, KV_W, KV_W, KV_W,
             NSA_HEADS * N_NSA_BRANCH, 2 * SGU_WIDTH, MEM_WIDTH, N_BRANCH * D_MODEL]
COL_IS_VALUE = [False, False, True, False, True, False, True, False, False, False, False]
SPLIT_POINTS = [int(v) for v in np.cumsum(COL_SIZES)[:-1]]
IN_WIDTH = int(sum(COL_SIZES))

kernel_name = "hybrid_nsa_sgu_mem_hmoe_deepnorm"


def layer_norm(x, g, b):
    xf = x.astype(jnp.float32)
    mu = xf.mean(-1, keepdims=True)
    var = jnp.mean(jnp.square(xf - mu), -1, keepdims=True)
    return ((xf - mu) * lax.rsqrt(var + LN_EPS) * g + b).astype(x.dtype)


def masked_softmax(s, mask):
    s = jnp.where(mask, s.astype(jnp.float32), NEG)
    m = s.max(-1, keepdims=True)
    e = jnp.where(mask, jnp.exp(s - m), 0.0)
    d = e.sum(-1, keepdims=True)
    return e / jnp.where(d > 0, d, 1.0)


def partial_rope(x, pos):
    half = ROPE_DIM // 2
    inv = ROPE_THETA ** (-jnp.arange(0, ROPE_DIM, 2, dtype=jnp.float32) / ROPE_DIM)
    ang = pos.astype(jnp.float32)[:, None] * inv[None, :]
    cos = jnp.cos(ang)[:, None, :]
    sin = jnp.sin(ang)[:, None, :]
    xf = x.astype(jnp.float32)
    x1, x2, xp = xf[..., :half], xf[..., half:ROPE_DIM], xf[..., ROPE_DIM:]
    out = jnp.concatenate([x1 * cos - x2 * sin, x2 * cos + x1 * sin, xp], axis=-1)
    return out.astype(x.dtype)


def compress_blocks(k, pe, w1, w2):
    B, S, G, D = k.shape
    n_cmp = (S - CMP_LEN) // CMP_STRIDE + 1
    idx = jnp.arange(n_cmp)[:, None] * CMP_STRIDE + jnp.arange(CMP_LEN)[None, :]
    blk = k[:, idx] + pe[None, None, :, None, :]
    blk = blk.transpose(0, 1, 3, 2, 4).reshape(B, n_cmp, G, CMP_LEN * D)
    return jax.nn.gelu(blk @ w1, approximate=False) @ w2


def band_blocks(k, nqb):
    B, S, G, D = k.shape
    kb = k.reshape(B, nqb, Q_BLOCK, G, D)
    kp = jnp.pad(kb, ((0, 0), (N_BAND, 0), (0, 0), (0, 0), (0, 0)))
    return jnp.concatenate([kp[:, i:i + nqb] for i in range(N_BAND + 1)], axis=2)


def nsa_mixer(q, kc, vc, ks, vs, kw, vw, gate_logits, pos,
              cmp_pe_k, cmp_w1_k, cmp_w2_k, cmp_pe_v, cmp_w1_v, cmp_w2_v):
    B, S = q.shape[:2]
    G, HPG, D = NSA_KV_GROUPS, NSA_HPG, HEAD_DIM
    dt = q.dtype
    scale = D ** -0.5
    qg = q.reshape(B, S, G, HPG, D)

    k_cmp = compress_blocks(kc, cmp_pe_k, cmp_w1_k, cmp_w2_k)
    v_cmp = compress_blocks(vc, cmp_pe_v, cmp_w1_v, cmp_w2_v)
    n_cmp = k_cmp.shape[1]
    s_cmp = jnp.einsum('bsghd,bngd->bghsn', qg, k_cmp) * scale
    cmp_end = jnp.arange(n_cmp) * CMP_STRIDE + CMP_LEN - 1
    cmp_mask = cmp_end[None, :] <= pos[:, None]
    p_cmp = masked_softmax(s_cmp, cmp_mask)
    o_cmp = jnp.einsum('bghsn,bngd->bsghd', p_cmp.astype(dt), v_cmp)

    n_sel = S // SLC_BLOCK
    top_n = min(SLC_TOPN, n_sel)
    ci = jnp.arange(n_cmp)
    sj = jnp.arange(n_sel)
    overlap = ((ci[:, None] * CMP_STRIDE + CMP_LEN - 1 >= sj[None, :] * SLC_BLOCK) &
               (ci[:, None] * CMP_STRIDE <= sj[None, :] * SLC_BLOCK + SLC_BLOCK - 1)).astype(jnp.float32)
    imp = jnp.einsum('bghsn,nj->bgsj', p_cmp, overlap)
    cur = pos // SLC_BLOCK
    future = sj[None, :] > cur[:, None]
    forced = (sj[None, :] == 0) | (sj[None, :] == cur[:, None]) | (sj[None, :] == cur[:, None] - 1)
    imp = jnp.where(future, NEG, jnp.where(forced, -NEG, imp))
    _, sel = lax.top_k(imp, top_n)

    ks_blk = ks.reshape(B, n_sel, SLC_BLOCK, G, D).transpose(0, 3, 1, 2, 4)
    vs_blk = vs.reshape(B, n_sel, SLC_BLOCK, G, D).transpose(0, 3, 1, 2, 4)
    nqb = S // Q_BLOCK
    q_blocks = qg.reshape(B, nqb, Q_BLOCK, G, HPG, D).transpose(1, 0, 3, 4, 2, 5)
    sel_blocks = sel.reshape(B, G, nqb, Q_BLOCK, top_n).transpose(2, 0, 1, 3, 4)
    pos_blocks = pos.reshape(nqb, Q_BLOCK)
    bi = jnp.arange(B)[:, None, None, None]
    gi = jnp.arange(G)[None, :, None, None]

    def sel_attend(args):
        qb, sb, tb = args
        kk = ks_blk[bi, gi, sb]
        vv = vs_blk[bi, gi, sb]
        s = jnp.einsum('bghqd,bgqnld->bghqnl', qb, kk) * scale
        kpos = sb[..., None] * SLC_BLOCK + jnp.arange(SLC_BLOCK)
        m = kpos <= tb[None, None, :, None, None]
        s = s.reshape(B, G, HPG, Q_BLOCK, top_n * SLC_BLOCK)
        m = m.reshape(B, G, 1, Q_BLOCK, top_n * SLC_BLOCK)
        pr = masked_softmax(s, m)
        return jnp.einsum('bghqk,bgqkd->bghqd', pr.astype(dt),
                          vv.reshape(B, G, Q_BLOCK, top_n * SLC_BLOCK, D))

    o_sel = lax.map(sel_attend, (q_blocks, sel_blocks, pos_blocks))
    o_sel = o_sel.transpose(1, 0, 4, 2, 3, 5).reshape(B, S, G, HPG, D)

    k_band = band_blocks(kw, nqb)
    v_band = band_blocks(vw, nqb)
    qw = qg.reshape(B, nqb, Q_BLOCK, G, HPG, D)
    s_win = jnp.einsum('bcqghd,bckgd->bcghqk', qw, k_band) * scale
    kw_len = (N_BAND + 1) * Q_BLOCK
    kpos = (jnp.arange(nqb)[:, None] - N_BAND) * Q_BLOCK + jnp.arange(kw_len)[None, :]
    diff = pos_blocks[:, :, None] - kpos[:, None, :]
    win_mask = (diff >= 0) & (diff < WINDOW) & (kpos[:, None, :] >= 0)
    p_win = masked_softmax(s_win, win_mask[None, :, None, None])
    o_win = jnp.einsum('bcghqk,bckgd->bcqghd', p_win.astype(dt), v_band).reshape(B, S, G, HPG, D)

    g = jax.nn.sigmoid(gate_logits).reshape(B, S, G, HPG, N_NSA_BRANCH)
    o = g[..., 0:1] * o_cmp + g[..., 1:2] * o_sel + g[..., 2:3] * o_win
    return o.reshape(B, S, NSA_HEADS * D)


def sgu_mixer(z, ln_g, ln_b, w_s, b_s):
    B, S, _ = z.shape
    u, v = z[..., :SGU_WIDTH], z[..., SGU_WIDTH:]
    v = layer_norm(v, ln_g, ln_b)
    nc = S // SGU_CHUNK
    v = v.reshape(B, nc, SGU_CHUNK, SGU_GROUPS, SGU_GROUP_DIM)
    tril = jnp.tril(jnp.ones((SGU_CHUNK, SGU_CHUNK), dtype=bool))
    ws = jnp.where(tril[None], w_s, 0.0).astype(z.dtype)
    sv = jnp.einsum('gts,bcsgd->bctgd', ws, v) + b_s.T[None, None, :, :, None]
    return u * sv.reshape(B, S, SGU_WIDTH)


def memory_attend(mq, mem, w_mem_kv):
    B, S, _ = mq.shape
    M = mem.shape[1]
    q = mq.reshape(B, S, MEM_HEADS, MEM_HEAD_DIM)
    kv = (mem @ w_mem_kv).reshape(B, M, 2, MEM_HEADS, MEM_HEAD_DIM)
    s = jnp.einsum('bshd,bmhd->bhsm', q, kv[:, :, 0]) * (MEM_HEAD_DIM ** -0.5)
    p = jax.nn.softmax(s.astype(jnp.float32), axis=-1).astype(mq.dtype)
    return jnp.einsum('bhsm,bmhd->bshd', p, kv[:, :, 1]).reshape(B, S, MEM_WIDTH)


def hier_moe(x, w_rg, b_rg, w_re, b_re, w_eg, w_eu, w_ed):
    B, S, Dm = x.shape
    T = B * S
    xt = x.reshape(T, Dm)
    gl = (xt @ w_rg + b_rg).astype(jnp.float32)
    gp = jax.nn.softmax(gl, axis=-1)
    gidx = jnp.argmax(gl, axis=-1)
    gprob = jnp.take_along_axis(gp, gidx[:, None], axis=-1)[:, 0]
    el = (xt @ w_re + b_re).astype(jnp.float32).reshape(T, N_GROUPS, EXPERTS_PER_GROUP)
    el = jnp.take_along_axis(el, gidx[:, None, None], axis=1)[:, 0]
    ep = jax.nn.softmax(el, axis=-1)
    tv, ti = lax.top_k(ep, TOP_K)
    tv = tv / tv.sum(-1, keepdims=True)
    ew = (jax.nn.one_hot(ti, EXPERTS_PER_GROUP, dtype=jnp.float32) * tv[..., None]).sum(1)
    cw = (jax.nn.one_hot(gidx, N_GROUPS, dtype=jnp.float32)[:, :, None]
          * ew[:, None, :] * gprob[:, None, None])
    cw = cw.astype(x.dtype).transpose(1, 0, 2)

    def group_ffn(args):
        wg, wu, wd, c = args
        h = jax.nn.silu(jnp.einsum('td,edf->tef', xt, wg)) * jnp.einsum('td,edf->tef', xt, wu)
        return jnp.einsum('tef,te,efd->td', h, c, wd)

    out = lax.map(group_ffn, (w_eg, w_eu, w_ed, cw)).sum(0)
    return out.reshape(B, S, Dm)


def hybrid_layer(x, mem, w_in, cmp_pe_k, cmp_w1_k, cmp_w2_k, cmp_pe_v, cmp_w1_v, cmp_w2_v,
                 sgu_ln_g, sgu_ln_b, sgu_w_s, sgu_b_s, w_mem_kv, w_br_nsa, w_br_sgu, w_br_mem,
                 w_o, ln1_g, ln1_b, w_router_group, b_router_group, w_router_expert,
                 b_router_expert, w_exp_gate, w_exp_up, w_exp_down, ln2_g, ln2_b):
    B, S, _ = x.shape
    pos = jnp.arange(S)
    h = x @ w_in
    (q, kc, vc, ksl, vsl, kwn, vwn, nsa_g, sgu_z, mq, merge_g) = jnp.split(h, SPLIT_POINTS, axis=-1)
    kv_shape = (B, S, NSA_KV_GROUPS, HEAD_DIM)
    q = partial_rope(q.reshape(B, S, NSA_HEADS, HEAD_DIM), pos)
    kc = partial_rope(kc.reshape(kv_shape), pos)
    ksl = partial_rope(ksl.reshape(kv_shape), pos)
    kwn = partial_rope(kwn.reshape(kv_shape), pos)
    o_nsa = nsa_mixer(q, kc, vc.reshape(kv_shape), ksl, vsl.reshape(kv_shape), kwn,
                      vwn.reshape(kv_shape), nsa_g, pos,
                      cmp_pe_k, cmp_w1_k, cmp_w2_k, cmp_pe_v, cmp_w1_v, cmp_w2_v)
    o_sgu = sgu_mixer(jax.nn.gelu(sgu_z, approximate=False), sgu_ln_g, sgu_ln_b, sgu_w_s, sgu_b_s)
    o_mem = memory_attend(mq, mem, w_mem_kv)
    g = jax.nn.sigmoid(merge_g).reshape(B, S, N_BRANCH, D_MODEL)
    y = (g[:, :, 0] * (o_nsa @ w_br_nsa) + g[:, :, 1] * (o_sgu @ w_br_sgu)
         + g[:, :, 2] * (o_mem @ w_br_mem))
    x = layer_norm(DN_ALPHA * x + y @ w_o, ln1_g, ln1_b)
    f = hier_moe(x, w_router_group, b_router_group, w_router_expert, b_router_expert,
                 w_exp_gate, w_exp_up, w_exp_down)
    return layer_norm(DN_ALPHA * x + f, ln2_g, ln2_b)


def setup_inputs(seed: int = 0) -> dict:
    key = jax.random.key(seed)
    ks = jax.random.split(key, 32)
    L = DEPTH

    def nrm(k, shape, scale):
        return jax.random.normal(k, shape, jnp.float32) * scale

    col_scale = jnp.asarray(np.concatenate(
        [np.full((n,), DN_BETA if v else 1.0, np.float32) for n, v in zip(COL_SIZES, COL_IS_VALUE)]))
    mem_scale = jnp.asarray(np.concatenate(
        [np.ones((MEM_WIDTH,), np.float32), np.full((MEM_WIDTH,), DN_BETA, np.float32)]))
    cmp_in = CMP_LEN * HEAD_DIM
    return {
        "x": nrm(ks[0], (BATCH, SEQ, D_MODEL), 1.0),
        "mem": nrm(ks[1], (BATCH, MEM_LEN, D_MODEL), 1.0),
        "w_in": nrm(ks[2], (L, D_MODEL, IN_WIDTH), D_MODEL ** -0.5) * col_scale,
        "cmp_pe_k": nrm(ks[3], (L, CMP_LEN, HEAD_DIM), 0.1),
        "cmp_w1_k": nrm(ks[4], (L, cmp_in, CMP_HIDDEN), cmp_in ** -0.5),
        "cmp_w2_k": nrm(ks[5], (L, CMP_HIDDEN, HEAD_DIM), CMP_HIDDEN ** -0.5),
        "cmp_pe_v": nrm(ks[6], (L, CMP_LEN, HEAD_DIM), 0.1),
        "cmp_w1_v": nrm(ks[7], (L, cmp_in, CMP_HIDDEN), cmp_in ** -0.5),
        "cmp_w2_v": nrm(ks[8], (L, CMP_HIDDEN, HEAD_DIM), CMP_HIDDEN ** -0.5),
        "sgu_ln_g": 1.0 + nrm(ks[9], (L, SGU_WIDTH), 0.02),
        "sgu_ln_b": nrm(ks[10], (L, SGU_WIDTH), 0.02),
        "sgu_w_s": nrm(ks[11], (L, SGU_GROUPS, SGU_CHUNK, SGU_CHUNK), SGU_CHUNK ** -0.5),
        "sgu_b_s": 1.0 + nrm(ks[12], (L, SGU_GROUPS, SGU_CHUNK), 0.02),
        "w_mem_kv": nrm(ks[13], (L, D_MODEL, 2 * MEM_WIDTH), D_MODEL ** -0.5) * mem_scale,
        "w_br_nsa": nrm(ks[14], (L, NSA_HEADS * HEAD_DIM, D_MODEL), (NSA_HEADS * HEAD_DIM) ** -0.5),
        "w_br_sgu": nrm(ks[15], (L, SGU_WIDTH, D_MODEL), SGU_WIDTH ** -0.5),
        "w_br_mem": nrm(ks[16], (L, MEM_WIDTH, D_MODEL), MEM_WIDTH ** -0.5),
        "w_o": nrm(ks[17], (L, D_MODEL, D_MODEL), D_MODEL ** -0.5) * DN_BETA,
        "ln1_g": 1.0 + nrm(ks[18], (L, D_MODEL), 0.02),
        "ln1_b": nrm(ks[19], (L, D_MODEL), 0.02),
        "w_router_group": nrm(ks[20], (L, D_MODEL, N_GROUPS), D_MODEL ** -0.5),
        "b_router_group": nrm(ks[21], (L, N_GROUPS), 0.01),
        "w_router_expert": nrm(ks[22], (L, D_MODEL, N_GROUPS * EXPERTS_PER_GROUP), D_MODEL ** -0.5),
        "b_router_expert": nrm(ks[23], (L, N_GROUPS * EXPERTS_PER_GROUP), 0.01),
        "w_exp_gate": nrm(ks[24], (L, N_GROUPS, EXPERTS_PER_GROUP, D_MODEL, EXPERT_FF), D_MODEL ** -0.5),
        "w_exp_up": nrm(ks[25], (L, N_GROUPS, EXPERTS_PER_GROUP, D_MODEL, EXPERT_FF), D_MODEL ** -0.5),
        "w_exp_down": nrm(ks[26], (L, N_GROUPS, EXPERTS_PER_GROUP, EXPERT_FF, D_MODEL),
                          EXPERT_FF ** -0.5) * DN_BETA,
        "ln2_g": 1.0 + nrm(ks[27], (L, D_MODEL), 0.02),
        "ln2_b": nrm(ks[28], (L, D_MODEL), 0.02),
    }


def reference(x, mem, w_in, cmp_pe_k, cmp_w1_k, cmp_w2_k, cmp_pe_v, cmp_w1_v, cmp_w2_v,
              sgu_ln_g, sgu_ln_b, sgu_w_s, sgu_b_s, w_mem_kv, w_br_nsa, w_br_sgu, w_br_mem,
              w_o, ln1_g, ln1_b, w_router_group, b_router_group, w_router_expert,
              b_router_expert, w_exp_gate, w_exp_up, w_exp_down, ln2_g, ln2_b):
    for l in range(DEPTH):
        x = hybrid_layer(x, mem, w_in[l], cmp_pe_k[l], cmp_w1_k[l], cmp_w2_k[l], cmp_pe_v[l],
                         cmp_w1_v[l], cmp_w2_v[l], sgu_ln_g[l], sgu_ln_b[l], sgu_w_s[l],
                         sgu_b_s[l], w_mem_kv[l], w_br_nsa[l], w_br_sgu[l], w_br_mem[l], w_o[l],
                         ln1_g[l], ln1_b[l], w_router_group[l], b_router_group[l],
                         w_router_expert[l], b_router_expert[l], w_exp_gate[l], w_exp_up[l],
                         w_exp_down[l], ln2_g[l], ln2_b[l])
    return x
```

```cpp
#include <hip/hip_runtime.h>
#include <cstdio>
#include <cstdint>
#ifndef MK_PER_PHASE
#define MK_PER_PHASE 0
#endif
#ifndef SELFCHECK
#define SELFCHECK 0
#endif
#ifndef CHECK_SEL
#define CHECK_SEL 0xFF
#endif
#ifndef WSUM_DPP
#define WSUM_DPP 1
#endif
__device__ __forceinline__ int lane_id() { return (int)__builtin_amdgcn_mbcnt_hi(~0u, __builtin_amdgcn_mbcnt_lo(~0u, 0u)); }
__device__ __forceinline__ int opaque_tid(int wv) { int t = wv * 64 + lane_id(); asm volatile("" : "+v"(t)); return t; }
#ifndef DRY_MODE
#define DRY_MODE 1
#endif
#if defined(DRY_PHASE) && defined(ATTN_PROBE)
#define PROBE_MODE_RT ((int)*(volatile __attribute__((address_space(3))) unsigned*)(960))
#else
#define PROBE_MODE_RT 0
#endif
#ifndef ATTN_DEFER
#define ATTN_DEFER 1
#endif
constexpr int NB = 8, SEQ = 2048, T = NB * SEQ, DM = 1024;
constexpr int NIN = 6144;
constexpr int C_Q = 0, C_KV = 512, C_SGU = 1280, C_MQ = 2304, C_MG = 2816, C_NG = 5888;
constexpr int S_Q = 0, S_NG = 1280, S_SGU = 1304, S_MQ = 2328, S_MG = 2840, IN_W = 5912;
constexpr int NEXP = 32, FF = 256, XS_ROWS = T * 2 + NEXP * 256;
constexpr float LN_EPS = 1e-5f, DN_ALPHA = 1.189207115002721f;
constexpr float LOG2E = 1.4426950408889634f;
constexpr float QSCALE = 0.125f * LOG2E;
constexpr float MQSCALE = 0.08838834764831845f * LOG2E;
constexpr int NWAVES = 8, NTHR = 512;

constexpr size_t MiB = 1u << 20, KiB = 1u << 10;
constexpr size_t WS_CTL = 0, CTL_ZERO_BYTES = 128 * KiB;
constexpr size_t WS_ROPE = 1 * MiB;
constexpr size_t WS_SGUW = 1 * MiB + 512 * KiB;
constexpr size_t WS_KCMP = 2 * MiB, WS_VCMP = 2 * MiB + 256 * KiB;
constexpr size_t WS_W2T = 2 * MiB + 512 * KiB;
constexpr size_t WS_TOK = 3 * MiB;
constexpr size_t WS_WRH = 3 * MiB + 512 * KiB, WS_WRL = 3 * MiB + 640 * KiB;
constexpr size_t WS_NG = 4 * MiB;
constexpr size_t WS_WMEMT = 6 * MiB;
constexpr size_t WS_WBRT = 8 * MiB;
constexpr size_t WS_WOT = 11 * MiB;
constexpr size_t WS_W1T = 13 * MiB;
constexpr size_t WS_TOKOF = 15 * MiB;
constexpr size_t WS_CWT = 15 * MiB + 256 * KiB;
constexpr size_t WS_WINT = 16 * MiB;
constexpr size_t WS_MEMBF = 28 * MiB;
constexpr size_t WS_XBF = 32 * MiB;
constexpr size_t WS_WGUT = 16 * MiB;
constexpr size_t WS_WDT = 48 * MiB;
constexpr size_t WS_Q = 64 * MiB;
constexpr size_t WS_KV = 80 * MiB;
constexpr size_t WS_Z = 104 * MiB;
constexpr size_t WS_Y = 104 * MiB;
constexpr size_t WS_MQ = 136 * MiB;
constexpr size_t WS_MG = 152 * MiB;
constexpr size_t WS_KVMEM = 248 * MiB;
constexpr size_t WS_XS = 64 * MiB;
constexpr size_t WS_H = 144 * MiB;
constexpr size_t WS_X1BF = 64 * MiB;
constexpr size_t WS_FBUF = 192 * MiB;
constexpr size_t WS_END = 256 * MiB;
constexpr size_t DO_OSGU = 0, DO_ONSA = 16 * MiB, DO_ONF = 32 * MiB;
static_assert(WS_X1BF + (size_t)T * 2048 <= WS_H && WS_H + (size_t)XS_ROWS * 256 * 2 <= WS_FBUF && WS_FBUF + (size_t)T * 4096 <= WS_END, "ws map");
constexpr int CW_CNT = 256;
constexpr int CW_BAR = 4096;

constexpr int LDS_MISC = 0;
constexpr int LDS_WORK = 1024;
constexpr int LDS_BYTES = 155648;
namespace pg8 {
#define PG8_LAS __attribute__((address_space(3)))
typedef unsigned short bf16_t;
typedef short bf16x8 __attribute__((ext_vector_type(8)));
typedef float f32x4 __attribute__((ext_vector_type(4)));
typedef unsigned u32x4 __attribute__((ext_vector_type(4)));
constexpr int BM = 256, BK = 64, HALF = 128, HTB = HALF * BK * 2  , STAGE_BYTES = 8 * HTB, NXCD = 8, WGM = 8;

__host__ __device__ __forceinline__ int lds_byte(int r, int c) { const int st = (r >> 4) * 2 + (c >> 5), rr = r & 15, cc = c & 31, ob = rr * 64 + cc * 2; return st * 1024 + (ob ^ (((ob >> 9) & 1) << 5)); }
__host__ __device__ __forceinline__ void stage_rc(int b, int& R, int& C) { const int st = b / 1024, sb = b % 1024, swz = sb ^ (((sb >> 9) & 1) << 5); R = (st >> 1) * 16 + swz / 64; C = (st & 1) * 32 + (swz % 64) / 2; }
__host__ __device__ __forceinline__ int perm32(int rho) { const int n = rho >> 4, i = rho & 15; return 8 * (i >> 2) + 4 * n + (i & 3); }

struct Unit { int pm, pn; };
struct Gemm { const bf16_t* A; const bf16_t* Bt; int M, N, K; };

struct StaticOrder {
    int nM, nN, nwg, G, c;
    __host__ __device__ void init(int M, int N, int G_, int c_) { nM = M / BM; nN = N / BM; nwg = nM * nN; G = G_; c = c_; }
    __host__ __device__ bool next(int i, Unit& u) const {
        const long L = (long)i * G + c; if (L >= nwg) return false;
        int wgid = (int)L; { const int q = nwg / NXCD, r = nwg % NXCD, xcd = wgid % NXCD, off = wgid / NXCD; wgid = (xcd < r ? xcd * (q + 1) : r * (q + 1) + (xcd - r) * q) + off; }
        const int nig = WGM * nN, gid = wgid / nig, fm = gid * WGM, gsz = (nM - fm) < WGM ? (nM - fm) : WGM;
        u.pm = fm + ((wgid % nig) % gsz); u.pn = (wgid % nig) / gsz; return true;
    }
    static constexpr bool GATHER = false;
    __device__ __forceinline__ unsigned rowoff(const Unit&, int) const { return 0u; }
    __device__ __forceinline__ void a_ready(const Unit&) const {}
    __device__ __forceinline__ void done(const Unit&) const {}
    __device__ __forceinline__ const char* pa(const Gemm& g, const Unit& u, size_t tstep) const { return (const char*)g.A + (size_t)u.pm * tstep; }
    __device__ __forceinline__ const char* pb(const Gemm& g, const Unit& u, size_t tstep) const { return (const char*)g.Bt + (size_t)u.pn * tstep; }
};

typedef float f32x2_t_ __attribute__((ext_vector_type(2))); typedef __bf16 bf16x2_t_ __attribute__((ext_vector_type(2)));
__device__ __forceinline__ unsigned cvt_pk_bf16(float lo, float hi) { f32x2_t_ v = {lo, hi}; bf16x2_t_ b = __builtin_convertvector(v, bf16x2_t_); return __builtin_bit_cast(unsigned, b); }
typedef float f32x2 __attribute__((ext_vector_type(2)));
__device__ __forceinline__ f32x2 gelu_pk(f32x2 v) {
    const f32x2 av = __builtin_elementwise_abs(v), d = av * 0.2316418882f + 1.0f;
    f32x2 t; t.x = __builtin_amdgcn_rcpf(d.x); t.y = __builtin_amdgcn_rcpf(d.y);
    f32x2 q = t * 0.5307027145f + (-0.7265760135f); q = q * t + 0.7107068705f; q = q * t + (-0.142248368f); q = q * t + 0.127414796f; q = q * t;
    const f32x2 s = (v * v) * (-0.72134752044f);
    f32x2 e; e.x = __builtin_amdgcn_exp2f(s.x); e.y = __builtin_amdgcn_exp2f(s.y);
    const f32x2 m = v * (q * e), r = v - m;
    f32x2 o; o.x = v.x < 0.f ? m.x : r.x; o.y = v.y < 0.f ? m.y : r.y; return o;
}

template <class Epi, class Sched, bool ALIGN_EPI = false, bool SP2 = false>
__device__ __forceinline__ void gemm_phase(PG8_LAS unsigned char* lds, const Gemm g, const Sched& S, const Epi& E, int wv) {
    const int tid = opaque_tid(wv), wid = __builtin_amdgcn_readfirstlane(tid >> 6), lane = tid & 63, wr = wid >> 2, wc = wid & 3, fr = lane & 15, fq = lane >> 4;
    const int K = g.K, nt = K / BK;
    unsigned voffA[2], voffB[2];
#pragma unroll
    for (int i = 0; i < 2; ++i) { int R, C; stage_rc(tid * 16 + i * 8192, R, C); const int Rb = Epi::PERM ? ((R & ~31) + perm32(R & 31)) : R;
        voffA[i] = (unsigned)(R * K + C) * 2u; voffB[i] = (unsigned)(Rb * K + C) * 2u; }
    const size_t kstep = (size_t)(BK * 2);
    const size_t hstep = (size_t)HALF * K * 2;
    const size_t tstep = 2 * hstep;
    const unsigned ldsw = (unsigned)wid * 1024u;
    const int aoff = lds_byte(wr * 64 + fr, fq * 8), boff = lds_byte(wc * 32 + fr, fq * 8);
#define PG8_SA(b, h) (((b) * 2 + (h)) * HTB)
#define PG8_SB(b, h) ((4 + (b) * 2 + (h)) * HTB)
#define PG8_STAGE(bufoff, gbase, voff) do { _Pragma("unroll") for (int _i = 0; _i < 2; ++_i) \
        __builtin_amdgcn_global_load_lds((const unsigned*)((const char*)(gbase) + (voff)[_i]), (PG8_LAS unsigned*)(lds + (bufoff) + ldsw + _i * 8192), 16, 0, 0); } while (0)
#define PG8_STAGE_A(bufoff, abase, h, VG) do { if constexpr (Sched::GATHER) { _Pragma("unroll") for (int _i = 0; _i < 2; ++_i) \
        __builtin_amdgcn_global_load_lds((const unsigned*)((const char*)(abase) + (VG)[h][_i]), (PG8_LAS unsigned*)(lds + (bufoff) + ldsw + _i * 8192), 16, 0, 0); } \
    else { PG8_STAGE(bufoff, (const char*)(abase) + (h) * hstep, voffA); } } while (0)
#define PG8_LDA(dst, b, h) do { _Pragma("unroll") for (int m = 0; m < 4; ++m) _Pragma("unroll") for (int k = 0; k < 2; ++k) dst[m][k] = *(const PG8_LAS bf16x8*)(lds + PG8_SA(b, h) + aoff + m * 2048 + k * 1024); } while (0)
#define PG8_LDB(dst, b, h) do { _Pragma("unroll") for (int n = 0; n < 2; ++n) _Pragma("unroll") for (int k = 0; k < 2; ++k) dst[n][k] = *(const PG8_LAS bf16x8*)(lds + PG8_SB(b, h) + boff + n * 2048 + k * 1024); } while (0)
#define PG8_MMA(ai, bj, At, Bt) do { __builtin_amdgcn_s_setprio(1); _Pragma("unroll") for (int m = 0; m < 4; ++m) _Pragma("unroll") for (int n = 0; n < 2; ++n) _Pragma("unroll") for (int k = 0; k < 2; ++k) \
        acc[ai][bj][m][n] = __builtin_amdgcn_mfma_f32_16x16x32_bf16(Bt[n][k], At[m][k], acc[ai][bj][m][n], 0, 0, 0); __builtin_amdgcn_s_setprio(0); } while (0)
#define PG8_WAIT_V(n) asm volatile("s_waitcnt vmcnt(" #n ")" ::: "memory")
#define PG8_WAIT_L(n) asm volatile("s_waitcnt lgkmcnt(" #n ")" ::: "memory")
#define PG8_BAR __builtin_amdgcn_s_barrier()
#define PG8_SCHED __builtin_amdgcn_sched_barrier(0)
    Unit cur, nxt; int ui = 0;
    if (!S.next(0, cur)) return;
    f32x4 acc[2][2][4][2];
#pragma unroll
    for (int a = 0; a < 2; ++a)
#pragma unroll
        for (int b = 0; b < 2; ++b)
#pragma unroll
            for (int m = 0; m < 4; ++m)
#pragma unroll
                for (int n = 0; n < 2; ++n) acc[a][b][m][n] = (f32x4){0.f, 0.f, 0.f, 0.f};
    bf16x8 At[4][2], B0[2][2], B1[2][2];
    const char* cA = S.pa(g, cur, tstep); const char* cB = S.pb(g, cur, tstep);
    S.a_ready(cur);
    unsigned VC[2][2] = {{0u, 0u}, {0u, 0u}}, VN[2][2] = {{0u, 0u}, {0u, 0u}};
    int gR[2], gC[2];
#pragma unroll
    for (int i = 0; i < 2; ++i) stage_rc(tid * 16 + i * 8192, gR[i], gC[i]);
    if constexpr (Sched::GATHER) {
#pragma unroll
        for (int h = 0; h < 2; ++h)
#pragma unroll
            for (int i = 0; i < 2; ++i) VC[h][i] = S.rowoff(cur, h * HALF + gR[i]) + (unsigned)gC[i] * 2u; }
    if constexpr (SP2) {
        PG8_STAGE(PG8_SB(0, 0), cB, voffB); PG8_STAGE(PG8_SB(0, 1), cB + hstep, voffB); PG8_STAGE_A(PG8_SA(0, 0), cA, 0, VC); PG8_STAGE_A(PG8_SA(0, 1), cA, 1, VC);
        if (wr == 1) PG8_BAR;
        PG8_WAIT_V(2); PG8_BAR;
        PG8_STAGE(PG8_SB(1, 0), cB + kstep, voffB); PG8_STAGE_A(PG8_SA(1, 0), cA + kstep, 0, VC); PG8_STAGE(PG8_SB(1, 1), cB + hstep + kstep, voffB);
        PG8_WAIT_V(6); PG8_BAR;
    } else {
        PG8_STAGE(PG8_SB(0, 0), cB, voffB); PG8_STAGE_A(PG8_SA(0, 0), cA, 0, VC); PG8_STAGE(PG8_SB(0, 1), cB + hstep, voffB); PG8_STAGE_A(PG8_SA(0, 1), cA, 1, VC);
        if (wr == 1) PG8_BAR;
        PG8_WAIT_V(4); PG8_BAR;
        PG8_STAGE(PG8_SB(1, 0), cB + kstep, voffB); PG8_STAGE_A(PG8_SA(1, 0), cA + kstep, 0, VC); PG8_STAGE(PG8_SB(1, 1), cB + hstep + kstep, voffB);
        PG8_WAIT_V(6); PG8_BAR;
    }
    for (;;) {
        const bool has_next = S.next(ui + 1, nxt);
        const char* nA = has_next ? S.pa(g, nxt, tstep) : cA; const char* nB = has_next ? S.pb(g, nxt, tstep) : cB;
        if constexpr (Sched::GATHER) {
#pragma unroll
            for (int h = 0; h < 2; ++h)
#pragma unroll
                for (int i = 0; i < 2; ++i) VN[h][i] = has_next ? S.rowoff(nxt, h * HALF + gR[i]) + (unsigned)gC[i] * 2u : VC[h][i]; }
        for (int t = 0; t < nt; t += 2) {
            const bool last = (t == nt - 2);
            const char* a1 = cA + (size_t)(t + 1) * kstep;
            const char* a2 = last ? nA : cA + (size_t)(t + 2) * kstep; const char* b2 = last ? nB : cB + (size_t)(t + 2) * kstep;
            const char* a3 = a2 + kstep; const char* b3 = b2 + kstep;
            if (last && has_next) S.a_ready(nxt);
            unsigned V2[2][2];
#pragma unroll
            for (int h = 0; h < 2; ++h)
#pragma unroll
                for (int i = 0; i < 2; ++i) V2[h][i] = last ? VN[h][i] : VC[h][i];
            if constexpr (SP2) {
            PG8_LDB(B0, 0, 0); PG8_LDB(B1, 0, 1); PG8_SCHED; PG8_LDA(At, 0, 0); PG8_STAGE_A(PG8_SA(1, 1), a1, 1, VC);
            PG8_WAIT_V(8); PG8_WAIT_L(0); PG8_BAR; PG8_MMA(0, 0, At, B0); PG8_MMA(0, 1, At, B1); PG8_BAR; PG8_SCHED;
            PG8_LDA(At, 0, 1); PG8_STAGE(PG8_SB(0, 0), b2, voffB); PG8_STAGE(PG8_SB(0, 1), b2 + hstep, voffB); PG8_STAGE_A(PG8_SA(0, 0), a2, 0, V2);
            PG8_WAIT_V(8); PG8_WAIT_L(0); PG8_BAR; PG8_MMA(1, 0, At, B0); PG8_MMA(1, 1, At, B1); PG8_BAR; PG8_SCHED;
            PG8_LDB(B0, 1, 0); PG8_LDB(B1, 1, 1); PG8_SCHED; PG8_LDA(At, 1, 0); PG8_STAGE_A(PG8_SA(0, 1), a2, 1, V2);
            PG8_WAIT_V(8); PG8_WAIT_L(0); PG8_BAR; PG8_MMA(0, 0, At, B0); PG8_MMA(0, 1, At, B1); PG8_BAR; PG8_SCHED;
            PG8_LDA(At, 1, 1); PG8_STAGE(PG8_SB(1, 0), b3, voffB); PG8_STAGE(PG8_SB(1, 1), b3 + hstep, voffB); PG8_STAGE_A(PG8_SA(1, 0), a3, 0, V2);
            PG8_WAIT_V(8); PG8_WAIT_L(0); PG8_BAR; PG8_MMA(1, 0, At, B0); PG8_MMA(1, 1, At, B1); PG8_BAR; PG8_SCHED;
            } else {
            PG8_LDB(B0, 0, 0); PG8_SCHED; PG8_LDA(At, 0, 0); PG8_STAGE_A(PG8_SA(1, 1), a1, 1, VC);
            PG8_WAIT_L(8); PG8_BAR; PG8_WAIT_L(0); PG8_MMA(0, 0, At, B0); PG8_BAR; PG8_SCHED;
            PG8_LDB(B1, 0, 1); PG8_STAGE(PG8_SB(0, 0), b2, voffB);
            PG8_BAR; PG8_WAIT_L(0); PG8_MMA(0, 1, At, B1); PG8_BAR;
            PG8_LDA(At, 0, 1); PG8_STAGE_A(PG8_SA(0, 0), a2, 0, V2);
            PG8_BAR; PG8_WAIT_L(0); PG8_MMA(1, 0, At, B0); PG8_BAR; PG8_SCHED;
            PG8_STAGE(PG8_SB(0, 1), b2 + hstep, voffB);
            PG8_WAIT_V(6); PG8_BAR; PG8_MMA(1, 1, At, B1); PG8_BAR;
            PG8_LDB(B0, 1, 0); PG8_SCHED; PG8_LDA(At, 1, 0); PG8_STAGE_A(PG8_SA(0, 1), a2, 1, V2);
            PG8_WAIT_L(8); PG8_BAR; PG8_WAIT_L(0); PG8_MMA(0, 0, At, B0); PG8_BAR; PG8_SCHED;
            PG8_LDB(B1, 1, 1); PG8_STAGE(PG8_SB(1, 0), b3, voffB);
            PG8_BAR; PG8_WAIT_L(0); PG8_MMA(0, 1, At, B1); PG8_BAR;
            PG8_LDA(At, 1, 1); PG8_STAGE_A(PG8_SA(1, 0), a3, 0, V2);
            PG8_BAR; PG8_WAIT_L(0); PG8_MMA(1, 0, At, B0); PG8_BAR; PG8_SCHED;
            PG8_STAGE(PG8_SB(1, 1), b3 + hstep, voffB);
            PG8_WAIT_V(6); PG8_BAR; PG8_MMA(1, 1, At, B1); PG8_BAR;
            }
        }
        if constexpr (ALIGN_EPI) { if (wr == 0) PG8_BAR; }
        if constexpr (!Epi::AFTER_DRAIN) { int fr2 = fr, fq2 = fq; asm volatile("" : "+v"(fr2), "+v"(fq2));
            E(acc, cur, wr, wc, fr2, fq2); S.done(cur); }
        if (!has_next) break;
        if (!E.keep(cur)) {
#pragma unroll
        for (int a = 0; a < 2; ++a)
#pragma unroll
            for (int b = 0; b < 2; ++b)
#pragma unroll
                for (int m = 0; m < 4; ++m)
#pragma unroll
                    for (int n = 0; n < 2; ++n) acc[a][b][m][n] = (f32x4){0.f, 0.f, 0.f, 0.f};
        }
        cur = nxt; cA = nA; cB = nB; ++ui;
        if constexpr (Sched::GATHER) {
#pragma unroll
            for (int h = 0; h < 2; ++h)
#pragma unroll
                for (int i = 0; i < 2; ++i) VC[h][i] = VN[h][i]; }
        if constexpr (ALIGN_EPI) { if (wr == 1) PG8_BAR; }
    }
    PG8_WAIT_V(0);
    if constexpr (!ALIGN_EPI) { if (wr == 0) PG8_BAR; }
    PG8_BAR;
    if constexpr (Epi::AFTER_DRAIN) { E.fused(acc, cur, wr, wc, fr, fq, lds, wid, lane); S.done(cur); }
#undef PG8_SA
#undef PG8_SB
#undef PG8_STAGE
#undef PG8_STAGE_A
#undef PG8_LDA
#undef PG8_LDB
#undef PG8_MMA
#undef PG8_WAIT_V
#undef PG8_WAIT_L
#undef PG8_BAR
#undef PG8_SCHED
}
}
#define GAS __attribute__((address_space(1)))
#define LAS __attribute__((address_space(3)))
typedef unsigned short bf16;
typedef unsigned u32x4 __attribute__((ext_vector_type(4)));
typedef unsigned u32x2 __attribute__((ext_vector_type(2)));
typedef float f32x4 __attribute__((ext_vector_type(4)));
typedef float f32x2 __attribute__((ext_vector_type(2)));
typedef short bf16x8 __attribute__((ext_vector_type(8)));
typedef short s16x4 __attribute__((ext_vector_type(4)));
typedef GAS unsigned gu32;
#define RLX_AGENT __ATOMIC_RELAXED, __HIP_MEMORY_SCOPE_AGENT
#define LDS_WAIT() asm volatile("s_waitcnt lgkmcnt(0)" ::: "memory")
#define VM_WAIT() asm volatile("s_waitcnt vmcnt(0)" ::: "memory")
__device__ __forceinline__ unsigned f2bf(float f) { unsigned u = __builtin_bit_cast(unsigned, f); return (u + 0x7fffu + ((u >> 16) & 1u)) >> 16; }
__device__ __forceinline__ unsigned pk2(float lo, float hi) { return f2bf(lo) | (f2bf(hi) << 16); }
__device__ __forceinline__ float bf2f(unsigned h) { return __builtin_bit_cast(float, h << 16); }
__device__ __forceinline__ float bflo(unsigned w) { return __builtin_bit_cast(float, w << 16); }
__device__ __forceinline__ float bfhi(unsigned w) { return __builtin_bit_cast(float, w & 0xffff0000u); }
__device__ __forceinline__ float fast_exp2(float x) { return __builtin_amdgcn_exp2f(x); }
__device__ __forceinline__ float sigmoidf_(float x) { return __builtin_amdgcn_rcpf(1.0f + fast_exp2(-x * LOG2E)); }
template <int CTRL> __device__ __forceinline__ float dpp(float x) { return __builtin_bit_cast(float, __builtin_amdgcn_mov_dpp(__builtin_bit_cast(int, x), CTRL, 0xf, 0xf, true)); }
__device__ __forceinline__ void swap16(unsigned& a, unsigned& b) { asm volatile("s_nop 1\n\tv_permlane16_swap_b32 %0, %1" : "+v"(a), "+v"(b)); }
__device__ __forceinline__ void swap32(unsigned& a, unsigned& b) { asm volatile("s_nop 1\n\tv_permlane32_swap_b32 %0, %1" : "+v"(a), "+v"(b)); }
__device__ __forceinline__ float xrow16_max(float x) {
    unsigned a = __builtin_bit_cast(unsigned, x), b = a; swap16(a, b); x = fmaxf(__builtin_bit_cast(float, a), __builtin_bit_cast(float, b));
    a = __builtin_bit_cast(unsigned, x); b = a; swap32(a, b); return fmaxf(__builtin_bit_cast(float, a), __builtin_bit_cast(float, b));
}
__device__ __forceinline__ float xrow16_sum(float x) {
    unsigned a = __builtin_bit_cast(unsigned, x), b = a; swap16(a, b); x = __builtin_bit_cast(float, a) + __builtin_bit_cast(float, b);
    a = __builtin_bit_cast(unsigned, x); b = a; swap32(a, b); return __builtin_bit_cast(float, a) + __builtin_bit_cast(float, b);
}
__device__ __forceinline__ unsigned xrow16_or(unsigned x) { unsigned a = x, b = x; swap16(a, b); x = a | b; a = x; b = x; swap32(a, b); return a | b; }
__device__ __forceinline__ unsigned xrow16_umax(unsigned x) { unsigned a = x, b = x; swap16(a, b); x = a > b ? a : b; a = x; b = x; swap32(a, b); return a > b ? a : b; }
__device__ __forceinline__ float wave_sum(float v) {
#if WSUM_DPP
    v += dpp<0xB1>(v); v += dpp<0x4E>(v); v += dpp<0x124>(v); v += dpp<0x128>(v);
    return __builtin_bit_cast(float, __builtin_amdgcn_readfirstlane(__builtin_bit_cast(int, xrow16_sum(v))));
#else
#pragma unroll
    for (int o = 1; o < 64; o <<= 1) v += __shfl_xor(v, o);
    return v;
#endif
}

__device__ __forceinline__ size_t mg_index(int pm, int j, int ai, int m, int bj, int wr, int wc, int fr, int fq) {
    return ((((size_t)(pm * 12 + j) * 2 + ai) * 4 + m) * 2 + bj) * 512 + (wr * 4 + wc) * 64 + fq * 16 + fr; }
struct EpiInProj {
    static constexpr bool PERM = true, AFTER_DRAIN = false;
    __device__ __forceinline__ bool keep(const pg8::Unit&) const { return false; }
    bf16 *Q, *KV, *Z, *MQ, *MG, *KVM; const float* rope;
    __device__ __forceinline__ void operator()(const f32x4 (&acc)[2][2][4][2], const pg8::Unit& u, int wr, int wc, int fr, int fq) const {
        const int pn = u.pn; const int row0 = u.pm * 256 + wr * 64 + fr; const int c0 = wc * 32 + 8 * fq;
        int kind; bf16* base; int ldc, colt;
        if (pn >= 100) { kind = 5; base = KVM; ldc = 1024; colt = (pn - 100) * 256; }
        else if (pn < 2) { kind = 0; base = Q; ldc = 512; colt = pn * 256; }
        else if (pn < 5) { kind = 1; base = KV; ldc = 768; colt = (pn - 2) * 256; }
        else if (pn < 9) { kind = 2; base = Z; ldc = 1024; colt = (pn - 5) * 256; }
        else if (pn < 11) { kind = 3; base = MQ; ldc = 512; colt = (pn - 9) * 256; }
        else { kind = 4; base = MG; ldc = 3072; colt = (pn - 11) * 256; }
        const bool ropew = (kind <= 1) && ((wc & 1) == 0);
#pragma unroll
        for (int ai = 0; ai < 2; ++ai)
#pragma unroll
            for (int m = 0; m < 4; ++m) {
                const int r = row0 + ai * 128 + m * 16;
#pragma unroll
                for (int bj = 0; bj < 2; ++bj) {
                    f32x4 v0 = acc[ai][bj][m][0], v1 = acc[ai][bj][m][1];
                    if (kind <= 1) {
                        if (ropew && (kind == 0 || bj == 0)) {
                            f32x4 p0, p1;
#pragma unroll
                            for (int i = 0; i < 4; ++i) { p0[i] = __shfl_xor(v0[i], 16); p1[i] = __shfl_xor(v1[i], 16); }
                            if (fq < 2) {
                                const f32x4* cs = (const f32x4*)(rope + (size_t)(r & (SEQ - 1)) * 16);
                                const f32x4 t0 = cs[0], t1 = cs[1], t2 = cs[2], t3 = cs[3];
                                const float sg = fq == 0 ? -1.f : 1.f;
                                v0[0] = v0[0] * t0[0] + sg * p0[0] * t0[1]; v0[1] = v0[1] * t0[2] + sg * p0[1] * t0[3];
                                v0[2] = v0[2] * t1[0] + sg * p0[2] * t1[1]; v0[3] = v0[3] * t1[2] + sg * p0[3] * t1[3];
                                v1[0] = v1[0] * t2[0] + sg * p1[0] * t2[1]; v1[1] = v1[1] * t2[2] + sg * p1[1] * t2[3];
                                v1[2] = v1[2] * t3[0] + sg * p1[2] * t3[1]; v1[3] = v1[3] * t3[2] + sg * p1[3] * t3[3];
                            }
                        }
                        if (kind == 0) { v0 = v0 * QSCALE; v1 = v1 * QSCALE; }
                    } else if (kind == 2) {
                        pg8::f32x2 a = pg8::gelu_pk((pg8::f32x2){v0[0], v0[1]}), b = pg8::gelu_pk((pg8::f32x2){v0[2], v0[3]}), c = pg8::gelu_pk((pg8::f32x2){v1[0], v1[1]}), d = pg8::gelu_pk((pg8::f32x2){v1[2], v1[3]});
                        v0 = (f32x4){a.x, a.y, b.x, b.y}; v1 = (f32x4){c.x, c.y, d.x, d.y};
                    } else if (kind == 3) { v0 = v0 * MQSCALE; v1 = v1 * MQSCALE; }
                    else if (kind == 4) {
#pragma unroll
                        for (int i = 0; i < 4; ++i) { v0[i] = sigmoidf_(v0[i]); v1[i] = sigmoidf_(v1[i]); }
                    }
                    { u32x4 w; w.x = pg8::cvt_pk_bf16(v0[0], v0[1]); w.y = pg8::cvt_pk_bf16(v0[2], v0[3]); w.z = pg8::cvt_pk_bf16(v1[0], v1[1]); w.w = pg8::cvt_pk_bf16(v1[2], v1[3]);
                      if (kind == 4) { u32x2 q8;
                          q8.x = (unsigned)(v0[0] * 255.f + 0.5f) | ((unsigned)(v0[1] * 255.f + 0.5f) << 8) | ((unsigned)(v0[2] * 255.f + 0.5f) << 16) | ((unsigned)(v0[3] * 255.f + 0.5f) << 24);
                          q8.y = (unsigned)(v1[0] * 255.f + 0.5f) | ((unsigned)(v1[1] * 255.f + 0.5f) << 8) | ((unsigned)(v1[2] * 255.f + 0.5f) << 16) | ((unsigned)(v1[3] * 255.f + 0.5f) << 24);
                          ((u32x2*)MG)[mg_index(u.pm, pn - 11, ai, m, bj, wr, wc, fr, fq)] = q8; }
                      else *(u32x4*)(base + (size_t)r * ldc + colt + bj * 128 + c0) = w; }
                }
            }
    }
};
struct EpiBf16Plain {
    static constexpr bool PERM = true, AFTER_DRAIN = false;
    __device__ __forceinline__ bool keep(const pg8::Unit&) const { return false; }
    bf16* O; int ldc;
    __device__ __forceinline__ void operator()(const f32x4 (&acc)[2][2][4][2], const pg8::Unit& u, int wr, int wc, int fr, int fq) const {
        const int row0 = u.pm * 256 + wr * 64 + fr, col0 = u.pn * 256 + wc * 32 + 8 * fq;
#pragma unroll
        for (int ai = 0; ai < 2; ++ai)
#pragma unroll
            for (int m = 0; m < 4; ++m)
#pragma unroll
                for (int bj = 0; bj < 2; ++bj) { const f32x4 v0 = acc[ai][bj][m][0], v1 = acc[ai][bj][m][1];
                    u32x4 w; w.x = pg8::cvt_pk_bf16(v0[0], v0[1]); w.y = pg8::cvt_pk_bf16(v0[2], v0[3]); w.z = pg8::cvt_pk_bf16(v1[0], v1[1]); w.w = pg8::cvt_pk_bf16(v1[2], v1[3]);
                    *(u32x4*)(O + (size_t)(row0 + ai * 128 + m * 16) * ldc + col0 + bj * 128) = w; }
    }
};
struct EpiBranch {
    static constexpr bool PERM = true, AFTER_DRAIN = false;
    bf16* Y; const bf16* MG;
    __device__ __forceinline__ bool keep(const pg8::Unit& u) const { return u.pn < 8; }
    __device__ __forceinline__ void operator()(f32x4 (&acc)[2][2][4][2], const pg8::Unit& u, int wr, int wc, int fr, int fq) const {
        const int row0 = u.pm * 256 + wr * 64 + fr, cin = wc * 32 + 8 * fq; const bool last = u.pn >= 8;
#pragma unroll
        for (int ai = 0; ai < 2; ++ai)
#pragma unroll
            for (int m = 0; m < 4; ++m)
#pragma unroll
                for (int bj = 0; bj < 2; ++bj) {
                    const size_t r = (size_t)(row0 + ai * 128 + m * 16); const int c = cin + bj * 128;
                    const u32x2* gp = (const u32x2*)MG + mg_index(u.pm, u.pn, ai, m, bj, wr, wc, fr, fq);
                    const u32x2 g = *gp; constexpr float Q = 1.0f / 255.0f;
                    float sc[8] = {(float)(g.x & 255u) * Q, (float)((g.x >> 8) & 255u) * Q, (float)((g.x >> 16) & 255u) * Q, (float)(g.x >> 24) * Q, (float)(g.y & 255u) * Q, (float)((g.y >> 8) & 255u) * Q, (float)((g.y >> 16) & 255u) * Q, (float)(g.y >> 24) * Q};
                    if (!last) { const u32x2 h = gp[(size_t)4 * 2 * 4 * 2 * 512];
                        const float nx[8] = {(float)(h.x & 255u) * Q, (float)((h.x >> 8) & 255u) * Q, (float)((h.x >> 16) & 255u) * Q, (float)(h.x >> 24) * Q, (float)(h.y & 255u) * Q, (float)((h.y >> 8) & 255u) * Q, (float)((h.y >> 16) & 255u) * Q, (float)(h.y >> 24) * Q};
#pragma unroll
                        for (int i = 0; i < 8; ++i) sc[i] = fmaxf(sc[i], 1e-30f) * __builtin_amdgcn_rcpf(fmaxf(nx[i], 1e-30f));
                    } else {
#pragma unroll
                        for (int i = 0; i < 8; ++i) sc[i] = fmaxf(sc[i], 1e-30f); }
                    f32x4& v0 = acc[ai][bj][m][0]; f32x4& v1 = acc[ai][bj][m][1];
                    v0[0] *= sc[0]; v0[1] *= sc[1]; v0[2] *= sc[2]; v0[3] *= sc[3]; v1[0] *= sc[4]; v1[1] *= sc[5]; v1[2] *= sc[6]; v1[3] *= sc[7];
                    if (last) { u32x4 w; w.x = pg8::cvt_pk_bf16(v0[0], v0[1]); w.y = pg8::cvt_pk_bf16(v0[2], v0[3]); w.z = pg8::cvt_pk_bf16(v1[0], v1[1]); w.w = pg8::cvt_pk_bf16(v1[2], v1[3]);
                        *(u32x4*)(Y + r * 1024 + (u.pn & 3) * 256 + c) = w; }
                }
    }
};
struct P4Order {
    pg8::StaticOrder so; const unsigned char* outb; const unsigned char* mq;
    __device__ __forceinline__ bool next(int i, pg8::Unit& u) const { const int pass = i % 3; if (!so.next(i / 3, u)) return false; u.pn += 4 * pass; return true; }
    static constexpr bool GATHER = false;
    __device__ __forceinline__ unsigned rowoff(const pg8::Unit&, int) const { return 0u; }
    __device__ __forceinline__ void a_ready(const pg8::Unit&) const {}
    __device__ __forceinline__ void done(const pg8::Unit&) const {}
    __device__ __forceinline__ const char* pa(const pg8::Gemm&, const pg8::Unit& u, size_t tstep) const { const size_t off = u.pn < 4 ? DO_ONSA : DO_OSGU;
        const unsigned char* b = u.pn < 8 ? outb + off : mq; return (const char*)b + (size_t)u.pm * tstep; }
    __device__ __forceinline__ const char* pb(const pg8::Gemm& g, const pg8::Unit& u, size_t tstep) const { return (const char*)g.Bt + (size_t)u.pn * tstep; }
};
struct EpiResid {
    static constexpr bool PERM = true, AFTER_DRAIN = false;
    __device__ __forceinline__ bool keep(const pg8::Unit&) const { return false; }
    const float* x; float* out;
    __device__ __forceinline__ void operator()(const f32x4 (&acc)[2][2][4][2], const pg8::Unit& u, int wr, int wc, int fr, int fq) const {
        const int row0 = u.pm * 256 + wr * 64 + fr, col0 = u.pn * 256 + wc * 32 + 8 * fq;
#pragma unroll
        for (int ai = 0; ai < 2; ++ai)
#pragma unroll
            for (int m = 0; m < 4; ++m)
#pragma unroll
                for (int bj = 0; bj < 2; ++bj) {
                    const size_t o = (size_t)(row0 + ai * 128 + m * 16) * 1024 + col0 + bj * 128;
                    const f32x4 x0 = __builtin_nontemporal_load((const f32x4*)(x + o)), x1 = __builtin_nontemporal_load((const f32x4*)(x + o + 4));
                    *(f32x4*)(out + o) = x0 * DN_ALPHA + acc[ai][bj][m][0]; *(f32x4*)(out + o + 4) = x1 * DN_ALPHA + acc[ai][bj][m][1];
                }
    }
};
struct P1Order {
    pg8::StaticOrder so; const bf16* memA; const bf16* memB;
    __device__ __forceinline__ bool next(int i, pg8::Unit& u) const {
        const long L = (long)i * so.G + so.c; if (L < so.nwg) return so.next(i, u);
        const int k = (int)(L - so.nwg); if (k >= 32) return false; u.pm = k & 7; u.pn = 100 + (k >> 3); return true; }
    static constexpr bool GATHER = false;
    __device__ __forceinline__ unsigned rowoff(const pg8::Unit&, int) const { return 0u; }
    __device__ __forceinline__ void a_ready(const pg8::Unit&) const {}
    __device__ __forceinline__ void done(const pg8::Unit&) const {}
    __device__ __forceinline__ const char* pa(const pg8::Gemm& g, const pg8::Unit& u, size_t tstep) const { return u.pn >= 100 ? (const char*)memA + (size_t)u.pm * tstep : (const char*)g.A + (size_t)u.pm * tstep; }
    __device__ __forceinline__ const char* pb(const pg8::Gemm& g, const pg8::Unit& u, size_t tstep) const { return u.pn >= 100 ? (const char*)memB + (size_t)(u.pn - 100) * tstep : (const char*)g.Bt + (size_t)u.pn * tstep; }
};
__device__ __forceinline__ void nsa_gates(const bf16* XB, const bf16* WG, float* NG, LAS unsigned char* lds, int vcu, int G, int tid) {
    const int lane = tid & 63, wave = tid >> 6, c = lane & 15, q4 = lane >> 4, kh = wave >> 2;
    LAS f32x4* xch = (LAS f32x4*)(lds + LDS_WORK);
    for (int blk = vcu; blk < T / 64; blk += G) { const int rt = blk * 4 + (wave & 3);
        f32x4 acc[2] = {{0.f, 0.f, 0.f, 0.f}, {0.f, 0.f, 0.f, 0.f}};
#pragma unroll 8
        for (int ks = 16 * kh; ks < 16 * kh + 16; ++ks) { const bf16x8 a = *(const bf16x8*)(XB + (size_t)(rt * 16 + c) * 1024 + 32 * ks + 8 * q4);
#pragma unroll
            for (int nb = 0; nb < 2; ++nb) { const bf16x8 b = *(const bf16x8*)(WG + (size_t)(16 * nb + c) * 1024 + 32 * ks + 8 * q4); acc[nb] = __builtin_amdgcn_mfma_f32_16x16x32_bf16(a, b, acc[nb], 0, 0, 0); } }
        if (kh) { xch[((wave & 3) * 2 + 0) * 64 + lane] = acc[0]; xch[((wave & 3) * 2 + 1) * 64 + lane] = acc[1]; }
        __syncthreads();
        if (!kh) {
#pragma unroll
            for (int nb = 0; nb < 2; ++nb) { const f32x4 o = xch[((wave & 3) * 2 + nb) * 64 + lane];
#pragma unroll
                for (int r = 0; r < 4; ++r) if (16 * nb + c < 24) NG[(size_t)(rt * 16 + 4 * q4 + r) * 32 + 16 * nb + c] = sigmoidf_(acc[nb][r] + o[r]); } }
        __syncthreads();
    }
}
#define XB_TMO      128
#define XB_XCNT(j)  (256  + 64 * (j))
#define XB_XSUB(j)  (1280 + 64 * (j))
#define XB_XGEN(j)  (2304 + 64 * (j))
#define XB_TOP      3328
#define XB_TOPGEN   3392
#define XCD_BAR_WORDS 3456
#define XB_SPIN_CAP (1u << 18)

__device__ __forceinline__ unsigned xb_ld(unsigned* p)              { return __hip_atomic_load(p, __ATOMIC_RELAXED, __HIP_MEMORY_SCOPE_AGENT); }
__device__ __forceinline__ unsigned xb_add(unsigned* p, unsigned v) { return __hip_atomic_fetch_add(p, v, __ATOMIC_RELAXED, __HIP_MEMORY_SCOPE_AGENT); }
__device__ __forceinline__ unsigned xb_xcc_id() { return (unsigned)__builtin_amdgcn_s_getreg((3 << 11) | 20) & 0xFu; }
#define XB_SPIN(cond, bar) do { unsigned _sp = 0; while (cond) { __builtin_amdgcn_s_sleep(1); \
    if ((++_sp & 255u) == 0u) { if (xb_ld(&(bar)[XB_TMO])) break; if (_sp > XB_SPIN_CAP) { atomicAdd(&(bar)[XB_TMO], 1u); break; } } } } while (0)

struct XcdBarrier {
    unsigned* bar; unsigned x; int wv;
    volatile LAS unsigned* st;
};

__device__ __forceinline__ XcdBarrier xcd_barrier_post(unsigned* bar, volatile LAS unsigned* st, int wv) {
    XcdBarrier b; b.bar = bar; b.x = xb_xcc_id(); b.st = st; b.wv = wv;
    if (wv == 0 && lane_id() == 0) (void)xb_add(&bar[XB_XCNT(b.x)], 1u);
    return b;
}
__device__ __forceinline__ void xcd_barrier_complete(unsigned* bar, unsigned x, unsigned& nloc, unsigned& nx) {
    const unsigned G = gridDim.x * gridDim.y * gridDim.z;
    unsigned sum, cnt, mine, sp = 0u;
    for (;;) {
        sum = 0u; cnt = 0u; mine = 0u;
#pragma unroll
        for (unsigned j = 0; j < 16; ++j) { const unsigned c = xb_ld(&bar[XB_XCNT(j)]); sum += c; cnt += (c > 0u) ? 1u : 0u; mine = (j == x) ? c : mine; }
        if (sum == G) break;
        __builtin_amdgcn_s_sleep(1);
        if ((++sp & 255u) == 0u) { if (xb_ld(&bar[XB_TMO])) break; if (sp > XB_SPIN_CAP) { atomicAdd(&bar[XB_TMO], 1u); break; } }
    }
    nloc = mine > 0u ? mine : 1u; nx = cnt > 0u ? cnt : 1u;
}

__device__ __forceinline__ void xcd_barrier(const XcdBarrier& b) {
    asm volatile("s_waitcnt vmcnt(0)" ::: "memory");
    __syncthreads();
    if (b.wv == 0 && lane_id() == 0) {
        unsigned* bar = b.bar;
        __builtin_amdgcn_s_waitcnt(0);
        unsigned nloc = b.st[0], nx = b.st[1];
        if (nloc == 0u) { xcd_barrier_complete(bar, b.x, nloc, nx); b.st[0] = nloc; b.st[1] = nx; }
        const unsigned old = xb_add(&bar[XB_XSUB(b.x)], 1u);
        const unsigned gen = old / nloc;
        if (old + 1u == (gen + 1u) * nloc) {
            __builtin_amdgcn_fence(__ATOMIC_RELEASE, "agent");
            asm volatile("s_waitcnt vmcnt(0)" ::: "memory");
            const unsigned og = xb_add(&bar[XB_TOP], 1u);
            const unsigned tg = og / nx;
            if (og + 1u == (tg + 1u) * nx) xb_add(&bar[XB_TOPGEN], 1u);
            else XB_SPIN(xb_ld(&bar[XB_TOPGEN]) == tg, bar);
            __builtin_amdgcn_fence(__ATOMIC_ACQUIRE, "agent");
            xb_add(&bar[XB_XGEN(b.x)], 1u);
            asm volatile("s_waitcnt vmcnt(0)" ::: "memory");
        } else {
            XB_SPIN(xb_ld(&bar[XB_XGEN(b.x)]) == gen, bar);
            __builtin_amdgcn_fence(__ATOMIC_ACQUIRE, "agent");
            asm volatile("s_waitcnt vmcnt(0)" ::: "memory");
        }
    }
    __syncthreads();
}
template <int D> struct ATile { static constexpr int PITCH = (D + 16) * 2, BYTES = 64 * PITCH, NL = D / 64; };
typedef short v4i16_t __attribute__((ext_vector_type(4)));
__device__ __forceinline__ s16x4 tr16(const LAS char* p) { return __builtin_bit_cast(s16x4, __builtin_amdgcn_ds_read_tr16_b64_v4i16((LAS v4i16_t*)p)); }

template <int D> __device__ __forceinline__ void tile_load(const bf16* base, size_t pitch, int tid, u32x4 (&r)[D / 64]) {
    constexpr int NCH = D / 8;
#pragma unroll
    for (int i = 0; i < D / 64; ++i) { const int id = tid + NTHR * i, row = id / NCH, ch = id % NCH; r[i] = *(const u32x4*)(base + (size_t)row * pitch + ch * 8); }
}
template <int D> __device__ __forceinline__ void tile_store(LAS char* dst, int tid, const u32x4 (&r)[D / 64]) {
    constexpr int NCH = D / 8;
#pragma unroll
    for (int i = 0; i < D / 64; ++i) { const int id = tid + NTHR * i, row = id / NCH, ch = id % NCH; *(LAS u32x4*)(dst + row * ATile<D>::PITCH + ch * 16) = r[i]; }
}

constexpr float DEFER_THR = 6.0f;
template <int D, int NCG, class MF>
__device__ __forceinline__ void attn_tile(const LAS char* Kt, const LAS char* Vt, const bf16x8 (&qf)[NCG][D / 32], f32x4 (&acc)[NCG][D / 16], float (&mrun)[NCG], float (&lrun)[NCG],
                                          int kpos0, int mode, bool lanepred, const MF& mf, int lane) {
    constexpr int P = ATile<D>::PITCH;
    const int c = lane & 15, q4 = lane >> 4;
    f32x4 s0[2][NCG], s1[2][NCG];
    __builtin_amdgcn_s_setprio(1);
#pragma unroll
    for (int s = 0; s < 2; ++s) {
        bf16x8 kf[2][D / 32];
#pragma unroll
        for (int h = 0; h < 2; ++h)
#pragma unroll
            for (int ks = 0; ks < D / 32; ++ks) kf[h][ks] = *(const LAS bf16x8*)(Kt + (32 * s + 16 * h + c) * P + (32 * ks + 8 * q4) * 2);
#pragma unroll
        for (int cg = 0; cg < NCG; ++cg) { s0[s][cg] = (f32x4){0.f, 0.f, 0.f, 0.f}; s1[s][cg] = (f32x4){0.f, 0.f, 0.f, 0.f};
#pragma unroll
            for (int ks = 0; ks < D / 32; ++ks) { s0[s][cg] = __builtin_amdgcn_mfma_f32_16x16x32_bf16(kf[0][ks], qf[cg][ks], s0[s][cg], 0, 0, 0); s1[s][cg] = __builtin_amdgcn_mfma_f32_16x16x32_bf16(kf[1][ks], qf[cg][ks], s1[s][cg], 0, 0, 0); } }
    }
    __builtin_amdgcn_s_setprio(0);
    if (mode == 1) {
#pragma unroll
        for (int s = 0; s < 2; ++s)
#pragma unroll
            for (int cg = 0; cg < NCG; ++cg)
#pragma unroll
                for (int r = 0; r < 4; ++r) { s0[s][cg][r] = lanepred ? s0[s][cg][r] : -__builtin_inff(); s1[s][cg][r] = lanepred ? s1[s][cg][r] : -__builtin_inff(); }
    } else if (mode == 2) {
#pragma unroll
        for (int s = 0; s < 2; ++s) { const int kb = kpos0 + 32 * s + 4 * q4;
#pragma unroll
            for (int r = 0; r < 4; ++r) { const bool a = mf.valid(kb + r), b = mf.valid(kb + 16 + r);
#pragma unroll
                for (int cg = 0; cg < NCG; ++cg) { s0[s][cg][r] = a ? s0[s][cg][r] : -__builtin_inff(); s1[s][cg][r] = b ? s1[s][cg][r] : -__builtin_inff(); } } } }
    float lm[NCG]; bool grow = false;
#pragma unroll
    for (int cg = 0; cg < NCG; ++cg) { float m = -__builtin_inff();
#pragma unroll
        for (int s = 0; s < 2; ++s) m = fmaxf(m, fmaxf(fmaxf(fmaxf(s0[s][cg][0], s0[s][cg][1]), fmaxf(s0[s][cg][2], s0[s][cg][3])), fmaxf(fmaxf(s1[s][cg][0], s1[s][cg][1]), fmaxf(s1[s][cg][2], s1[s][cg][3]))));
        lm[cg] = m; grow = grow || (m > mrun[cg] + DEFER_THR); }
    if (PROBE_MODE_RT != 3 && __builtin_amdgcn_ballot_w64(grow) != 0ull) {
#pragma unroll
        for (int cg = 0; cg < NCG; ++cg) { const float mnew = fmaxf(mrun[cg], xrow16_max(lm[cg])), alpha = fast_exp2(mrun[cg] - mnew);
            mrun[cg] = mnew; lrun[cg] *= alpha;
#pragma unroll
            for (int db = 0; db < D / 16; ++db) acc[cg][db] = acc[cg][db] * alpha; }
    }
    bf16x8 pfv[2][NCG];
#pragma unroll
    for (int s = 0; s < 2; ++s)
#pragma unroll
        for (int cg = 0; cg < NCG; ++cg) { const float mr = mrun[cg]; float ps = 0.f; float p0[4], p1[4];
#pragma unroll
            for (int r = 0; r < 4; ++r) { p0[r] = PROBE_MODE_RT == 3 ? s0[s][cg][r] : fast_exp2(s0[s][cg][r] - mr); p1[r] = PROBE_MODE_RT == 3 ? s1[s][cg][r] : fast_exp2(s1[s][cg][r] - mr); ps += p0[r] + p1[r]; }
            lrun[cg] += ps;
            union { bf16x8 v; unsigned u[4]; } pf;
            pf.u[0] = pg8::cvt_pk_bf16(p0[0], p0[1]); pf.u[1] = pg8::cvt_pk_bf16(p0[2], p0[3]); pf.u[2] = pg8::cvt_pk_bf16(p1[0], p1[1]); pf.u[3] = pg8::cvt_pk_bf16(p1[2], p1[3]);
            pfv[s][cg] = pf.v; }
    __builtin_amdgcn_s_setprio(1);
#pragma unroll
    for (int s = 0; s < 2; ++s) {
        bf16x8 vf[D / 16];
#pragma unroll
        for (int db = 0; db < D / 16; ++db) {
            const LAS char* vp = Vt + (32 * s + 4 * q4 + (c >> 2)) * P + (16 * db + 4 * (c & 3)) * 2;
            const s16x4 lo = tr16(vp), hi = tr16(vp + 16 * P);
            vf[db] = (bf16x8){lo[0], lo[1], lo[2], lo[3], hi[0], hi[1], hi[2], hi[3]};
        }
#pragma unroll
        for (int cg = 0; cg < NCG; ++cg)
#pragma unroll
            for (int db = 0; db < D / 16; ++db) acc[cg][db] = __builtin_amdgcn_mfma_f32_16x16x32_bf16(vf[db], pfv[s][cg], acc[cg][db], 0, 0, 0);
    }
    __builtin_amdgcn_s_setprio(0);
}

template <int D, int NCG, int TPI, class MF>
__device__ __forceinline__ void attn_loop(LAS char* buf, const bf16* Kb, const bf16* Vb, size_t pitch, int t_lo, int t_hi, const MF& mf,
                                          const bf16x8 (&qf)[NCG][D / 32], f32x4 (&acc)[NCG][D / 16], float (&mrun)[NCG], float (&lrun)[NCG], int tid, int lane) {
    constexpr int TB = ATile<D>::BYTES, BUFB = 2 * TPI * TB;
    u32x4 ka[TPI][D / 64], va[TPI][D / 64], kb[TPI][D / 64], vb[TPI][D / 64];
#define ATT_LOAD(K_, V_, T0) do { _Pragma("unroll") for (int i = 0; i < TPI; ++i) if ((T0) + i <= t_hi) { tile_load<D>(Kb + (size_t)((T0) + i) * 64 * pitch, pitch, tid, K_[i]); tile_load<D>(Vb + (size_t)((T0) + i) * 64 * pitch, pitch, tid, V_[i]); } } while (0)
#define ATT_STORE(K_, V_, T0, B_) do { _Pragma("unroll") for (int i = 0; i < TPI; ++i) if ((T0) + i <= t_hi) { tile_store<D>((B_) + i * TB, tid, K_[i]); tile_store<D>((B_) + (TPI + i) * TB, tid, V_[i]); } } while (0)
#define ATT_COMP(T0, B_) do { _Pragma("unroll") for (int i = 0; i < TPI; ++i) if ((T0) + i <= t_hi && !mf.skip((T0) + i)) \
        attn_tile<D, NCG, MF>((B_) + i * TB, (B_) + (TPI + i) * TB, qf, acc, mrun, lrun, ((T0) + i) * 64, mf.mode((T0) + i), mf.lanepred((T0) + i), mf, lane); } while (0)
    ATT_LOAD(ka, va, t_lo); ATT_STORE(ka, va, t_lo, buf);
    ATT_LOAD(ka, va, t_lo + TPI);
    __syncthreads();
    for (int t = t_lo; t <= t_hi; t += 2 * TPI) {
        ATT_LOAD(kb, vb, t + 2 * TPI);
        ATT_COMP(t, buf);
        ATT_STORE(ka, va, t + TPI, buf + BUFB);
        __syncthreads();
        if (t + TPI > t_hi) break;
        ATT_LOAD(ka, va, t + 3 * TPI);
        ATT_COMP(t + TPI, buf + BUFB);
        ATT_STORE(kb, vb, t + 2 * TPI, buf);
        __syncthreads();
    }
#undef ATT_LOAD
#undef ATT_STORE
#undef ATT_COMP
}

template <int D, int NCG, int NT, class MF>
__device__ __forceinline__ void attn_all(LAS char* buf, const bf16* Kb, const bf16* Vb, size_t pitch, const MF& mf,
                                         const bf16x8 (&qf)[NCG][D / 32], f32x4 (&acc)[NCG][D / 16], float (&mrun)[NCG], float (&lrun)[NCG], int tid, int lane) {
    constexpr int TB = ATile<D>::BYTES;
    u32x4 rk[NT][D / 64], rv[NT][D / 64];
#pragma unroll
    for (int i = 0; i < NT; ++i) { tile_load<D>(Kb + (size_t)i * 64 * pitch, pitch, tid, rk[i]); tile_load<D>(Vb + (size_t)i * 64 * pitch, pitch, tid, rv[i]); }
#pragma unroll
    for (int i = 0; i < NT; ++i) { tile_store<D>(buf + i * TB, tid, rk[i]); tile_store<D>(buf + (NT + i) * TB, tid, rv[i]); }
    __syncthreads();
#pragma unroll 1
    for (int i = 0; i < NT; ++i) attn_tile<D, NCG, MF>(buf + i * TB, buf + (NT + i) * TB, qf, acc, mrun, lrun, i * 64, 0, false, mf, lane);
    __syncthreads();
}
struct Args {
    const float* in[29]; float* out; unsigned char* ws; int ph_lo, ph_hi, sub, pad;
};
enum { I_X = 0, I_MEM, I_WIN, I_PEK, I_W1K, I_W2K, I_PEV, I_W1V, I_W2V, I_SLNG, I_SLNB, I_SWS, I_SBS, I_WMEMKV, I_WBRN, I_WBRS, I_WBRM, I_WO, I_LN1G, I_LN1B,
       I_WRG, I_BRG, I_WRE, I_BRE, I_WEG, I_WEU, I_WED, I_LN2G, I_LN2B };

template <bool NT_STORE = false>
__device__ __forceinline__ void tr_item(const float* W, int ldw, int k0, int col0, int ncols, bf16* WT, int ldt, int row0, LAS float* scr, int lane) {
#pragma unroll 8
    for (int i = 0; i < 32; ++i) { const int kk = 2 * i + (lane >> 5), nn = lane & 31; scr[kk * 33 + nn] = nn < ncols ? __builtin_nontemporal_load(W + (size_t)(k0 + kk) * ldw + col0 + nn) : 0.f; }
    LDS_WAIT(); asm volatile("" ::: "memory");
    const int c = lane & 7;
#pragma unroll
    for (int j = 0; j < 4; ++j) { const int n = (lane >> 3) + 8 * j; const LAS float* s = scr + (8 * c) * 33 + n;
        u32x4 o; o.x = pk2(s[0 * 33], s[1 * 33]); o.y = pk2(s[2 * 33], s[3 * 33]); o.z = pk2(s[4 * 33], s[5 * 33]); o.w = pk2(s[6 * 33], s[7 * 33]);
        if (NT_STORE) __builtin_nontemporal_store(o, (u32x4*)(WT + (size_t)(row0 + n) * ldt + k0 + 8 * c)); else *(u32x4*)(WT + (size_t)(row0 + n) * ldt + k0 + 8 * c) = o; }
    LDS_WAIT(); asm volatile("" ::: "memory");
}
__device__ __forceinline__ bool tr_job(int& it, const float* W, int ldw, int K, int col0, int ncols, bf16* WT, int row0, LAS float* scr, int lane) {
    const int nb = (ncols + 31) / 32, n_items = (K / 64) * nb;
    if (it >= n_items) { it -= n_items; return false; }
    const int kb = it / nb, b = it % nb; const int rem = ncols - 32 * b;
    tr_item(W, ldw, 64 * kb, col0 + 32 * b, rem < 32 ? rem : 32, WT, K, row0 + 32 * b, scr, lane);
    return true;
}
__device__ __forceinline__ void cvt_rows_bf16(const float* src, bf16* dst, size_t n8, int gtid, int gthreads) {
    for (size_t i = gtid; i < n8; i += gthreads) { const f32x4 a = __builtin_nontemporal_load((const f32x4*)src + 2 * i), b = __builtin_nontemporal_load((const f32x4*)src + 2 * i + 1);
        u32x4 o; o.x = pk2(a[0], a[1]); o.y = pk2(a[2], a[3]); o.z = pk2(b[0], b[1]); o.w = pk2(b[2], b[3]); ((u32x4*)dst)[i] = o; }
}
__device__ __forceinline__ void p0_prologue(const Args& A, LAS unsigned char* lds, int vcu, int G, int wv) {
    const int tid = opaque_tid(wv), lane = tid & 63, wave = tid >> 6;
    unsigned char* ws = A.ws;
    LAS float* scr = (LAS float*)(lds + LDS_WORK + wave * 16384);
    const int gw = vcu * NWAVES + wave, NGW = G * NWAVES;
    bf16* WINT = (bf16*)(ws + WS_WINT);
    constexpr int N_ITEMS = 16 * (40 + 32 + 16 + 96 + 1) + 16 * 32 + 3 * 8 * 32 + 16 * 32 + 2 * 32 * 8 + 2 * 4 * 2;
    for (int it0 = gw; it0 < N_ITEMS; it0 += NGW) {
        int it = it0;
        if (tr_job(it, A.in[I_WIN], IN_W, 1024, S_Q, 1280, WINT, C_Q, scr, lane)) continue;
        if (tr_job(it, A.in[I_WIN], IN_W, 1024, S_SGU, 1024, WINT, C_SGU, scr, lane)) continue;
        if (tr_job(it, A.in[I_WIN], IN_W, 1024, S_MQ, 512, WINT, C_MQ, scr, lane)) continue;
        if (tr_job(it, A.in[I_WIN], IN_W, 1024, S_MG, 3072, WINT, C_MG, scr, lane)) continue;
        if (tr_job(it, A.in[I_WIN], IN_W, 1024, S_NG, 24, WINT, C_NG, scr, lane)) continue;
        if (tr_job(it, A.in[I_WMEMKV], 1024, 1024, 0, 1024, (bf16*)(ws + WS_WMEMT), 0, scr, lane)) continue;
        if (tr_job(it, A.in[I_WBRN], 1024, 512, 0, 1024, (bf16*)(ws + WS_WBRT), 0, scr, lane)) continue;
        if (tr_job(it, A.in[I_WBRS], 1024, 512, 0, 1024, (bf16*)(ws + WS_WBRT) + 1024 * 512, 0, scr, lane)) continue;
        if (tr_job(it, A.in[I_WBRM], 1024, 512, 0, 1024, (bf16*)(ws + WS_WBRT) + 2 * 1024 * 512, 0, scr, lane)) continue;
        if (tr_job(it, A.in[I_WO], 1024, 1024, 0, 1024, (bf16*)(ws + WS_WOT), 0, scr, lane)) continue;
        if (tr_job(it, A.in[I_W1K], 256, 2048, 0, 256, (bf16*)(ws + WS_W1T), 0, scr, lane)) continue;
        if (tr_job(it, A.in[I_W1V], 256, 2048, 0, 256, (bf16*)(ws + WS_W1T) + 256 * 2048, 0, scr, lane)) continue;
        if (tr_job(it, A.in[I_W2K], 64, 256, 0, 64, (bf16*)(ws + WS_W2T), 0, scr, lane)) continue;
        tr_job(it, A.in[I_W2V], 64, 256, 0, 64, (bf16*)(ws + WS_W2T) + 64 * 256, 0, scr, lane);
    }
    const int gtid = vcu * NTHR + tid, gthreads = G * NTHR;
    for (int i = gtid; i < 224 * 1024 / 8; i += gthreads) ((u32x4*)(WINT + (size_t)5920 * 1024))[i] = (u32x4){0u, 0u, 0u, 0u};
    cvt_rows_bf16(A.in[I_X], (bf16*)(ws + WS_XBF), (size_t)T * DM / 8, gtid, gthreads);
    cvt_rows_bf16(A.in[I_MEM], (bf16*)(ws + WS_MEMBF), (size_t)NB * 256 * DM / 8, gtid, gthreads);
    for (int i = gtid; i < 8 * 128 * 128; i += gthreads) { const int s = i & 127, t = (i >> 7) & 127; ((bf16*)(ws + WS_SGUW))[i] = (bf16)(s <= t ? f2bf(A.in[I_SWS][i]) : 0u); }
    for (int i = gtid; i < 48 * 1024; i += gthreads) { const int o = i >> 10, k = i & 1023; const float w = o < 4 ? A.in[I_WRG][k * 4 + o] : o < 36 ? A.in[I_WRE][k * 32 + o - 4] : 0.f;
        const unsigned h = f2bf(w); ((bf16*)(ws + WS_WRH))[i] = (bf16)h; ((bf16*)(ws + WS_WRL))[i] = (bf16)f2bf(w - bf2f(h)); }
    for (int i = gtid; i < SEQ * 8; i += gthreads) { const int pos = i >> 3, k = i & 7;
        const float inv = (float)pow(500000.0, -(double)k / 8.0); const float ang = (float)pos * inv;
        ((f32x2*)(ws + WS_ROPE))[i] = (f32x2){(float)cos((double)ang), (float)sin((double)ang)}; }
}
__device__ __forceinline__ void convert_experts(const Args& A, LAS unsigned char* lds, int vcu, int G, int wv) {
    const int tid = opaque_tid(wv), lane = tid & 63, wave = tid >> 6;
    LAS float* scr = (LAS float*)(lds + LDS_WORK + wave * 16384);
    bf16* WGUT = (bf16*)(A.ws + WS_WGUT); bf16* WDT = (bf16*)(A.ws + WS_WDT);
    constexpr int PER_E = 2 * 16 * 8 + 4 * 32;
    const bool weighted = (G == 256); const int nslot = weighted ? 128 * NWAVES : G * NWAVES;
    const int myn = weighted ? (vcu < 128 ? 0 : 1) : 1, my0 = weighted ? (vcu - 128) * NWAVES + wave : vcu * NWAVES + wave;
    for (int sl = 0; sl < myn; ++sl)
    for (int it0 = my0 + sl; it0 < NEXP * PER_E; it0 += nslot) {
        const int e = it0 / PER_E; int it = it0 % PER_E;
        if (it < 256) { const bool up = it >= 128; it &= 127; const int kb = it >> 3, cb = it & 7, f0 = 32 * cb;
            tr_item<true>(A.in[up ? I_WEU : I_WEG] + (size_t)e * 1024 * 256, 256, 64 * kb, f0, 32, WGUT, 1024, e * 512 + (f0 >> 7) * 256 + (up ? 128 : 0) + (f0 & 127), scr, lane);
        } else { it -= 256; const int kb = it >> 5, cb = it & 31;
            tr_item<true>(A.in[I_WED] + (size_t)e * 256 * 1024, 1024, 64 * kb, 32 * cb, 32, WDT, 256, e * 1024 + 32 * cb, scr, lane); }
    }
}
__device__ __forceinline__ void compress_unit(const Args& A, LAS unsigned char* lds, int unit, int wv) {
    const int tid = opaque_tid(wv), lane = tid & 63, wave = __builtin_amdgcn_readfirstlane(tid >> 6), c = lane & 15, q4 = lane >> 4;
    const int kv = unit >> 6, g = (unit >> 5) & 1, rb = unit & 31;
    const bf16* KV = (const bf16*)(A.ws + WS_KV); const float* pe = A.in[kv ? I_PEV : I_PEK];
    const bf16* W1T = (const bf16*)(A.ws + WS_W1T) + (size_t)kv * 256 * 2048; const bf16* W2T = (const bf16*)(A.ws + WS_W2T) + kv * 64 * 256;
    bf16* OUT = (bf16*)(A.ws + (kv ? WS_VCMP : WS_KCMP));
    const int coloff = kv * 128 + g * 64;
    constexpr int AP = 2048 + 8;
    LAS bf16* Aimg = (LAS bf16*)(lds + LDS_WORK); LAS bf16* hid = Aimg + 32 * AP;
    { const int bA = (rb * 32) >> 7, n0 = (rb * 32) & 127;
#pragma unroll 8
      for (int i = 0; i < 16; ++i) { const int id = tid + NTHR * i;
          const int r = id >> 8, l = (id >> 3) & 31, ch = id & 7; int tok = (n0 + r) * 16 + l; tok = tok < SEQ ? tok : SEQ - 1;
          const u32x4 kraw = *(const u32x4*)(KV + (size_t)(bA * SEQ + tok) * 768 + coloff + ch * 8);
          const f32x4 pe0 = *(const f32x4*)(pe + l * 64 + ch * 8), pe1 = *(const f32x4*)(pe + l * 64 + ch * 8 + 4);
          u32x4 o; o.x = pg8::cvt_pk_bf16(bflo(kraw.x) + pe0[0], bfhi(kraw.x) + pe0[1]); o.y = pg8::cvt_pk_bf16(bflo(kraw.y) + pe0[2], bfhi(kraw.y) + pe0[3]);
          o.z = pg8::cvt_pk_bf16(bflo(kraw.z) + pe1[0], bfhi(kraw.z) + pe1[1]); o.w = pg8::cvt_pk_bf16(bflo(kraw.w) + pe1[2], bfhi(kraw.w) + pe1[3]);
          *(LAS u32x4*)(Aimg + r * AP + l * 64 + ch * 8) = o; } }
    __syncthreads();
    f32x4 acc[2][2] = {{{0.f, 0.f, 0.f, 0.f}, {0.f, 0.f, 0.f, 0.f}}, {{0.f, 0.f, 0.f, 0.f}, {0.f, 0.f, 0.f, 0.f}}};
#pragma unroll 8
    for (int ks = 0; ks < 64; ++ks) {
        const bf16x8 a0 = *(const LAS bf16x8*)(Aimg + c * AP + 32 * ks + 8 * q4), a1 = *(const LAS bf16x8*)(Aimg + (16 + c) * AP + 32 * ks + 8 * q4);
#pragma unroll
        for (int nb = 0; nb < 2; ++nb) { const bf16x8 bfr = *(const bf16x8*)(W1T + (size_t)(32 * wave + 16 * nb + c) * 2048 + 32 * ks + 8 * q4);
            acc[0][nb] = __builtin_amdgcn_mfma_f32_16x16x32_bf16(a0, bfr, acc[0][nb], 0, 0, 0); acc[1][nb] = __builtin_amdgcn_mfma_f32_16x16x32_bf16(a1, bfr, acc[1][nb], 0, 0, 0); }
    }
#pragma unroll
    for (int mt = 0; mt < 2; ++mt)
#pragma unroll
        for (int nb = 0; nb < 2; ++nb)
#pragma unroll
            for (int r = 0; r < 4; ++r) { const float x = acc[mt][nb][r]; const pg8::f32x2 gg = pg8::gelu_pk((pg8::f32x2){x, x}); hid[(16 * mt + 4 * q4 + r) * 264 + 32 * wave + 16 * nb + c] = (bf16)f2bf(gg.x); }
    __syncthreads();
    { const int mt = wave >> 2, nt = wave & 3;
      f32x4 o = {0.f, 0.f, 0.f, 0.f};
#pragma unroll
      for (int ks = 0; ks < 8; ++ks) { const bf16x8 a = *(const LAS bf16x8*)(hid + (16 * mt + c) * 264 + 32 * ks + 8 * q4); const bf16x8 b = *(const bf16x8*)(W2T + (16 * nt + c) * 256 + 32 * ks + 8 * q4);
          o = __builtin_amdgcn_mfma_f32_16x16x32_bf16(a, b, o, 0, 0, 0); }
#pragma unroll
      for (int r = 0; r < 4; ++r) { const int row = rb * 32 + 16 * mt + 4 * q4 + r, n = row & 127; OUT[((size_t)row * 2 + g) * 64 + 16 * nt + c] = (bf16)(n == 127 ? 0u : f2bf(o[r])); } }
    __syncthreads();
}

__device__ __forceinline__ void sgu_unit(const Args& A, LAS unsigned char* lds, int unit, int wv) {
    const int tid = opaque_tid(wv), lane = tid & 63, wave = __builtin_amdgcn_readfirstlane(tid >> 6), c = lane & 15, q4 = lane >> 4;
    const int half = unit & 1, bc = unit >> 1; const size_t row0 = (size_t)bc * 128;
    const bf16* Z = (const bf16*)(A.ws + WS_Z); bf16* OS = (bf16*)((unsigned char*)A.out + DO_OSGU);
    constexpr int VP = (256 + 16) * 2;
    LAS char* Vr = (LAS char*)(lds + LDS_WORK);
    { u32x4 w[16];
#pragma unroll
      for (int i = 0; i < 16; ++i) w[i] = *(const u32x4*)(Z + (row0 + wave * 16 + i) * 1024 + 512 + lane * 8);
      const float* lg = A.in[I_SLNG] + lane * 8; const float* lb = A.in[I_SLNB] + lane * 8;
      const f32x4 g0 = *(const f32x4*)lg, g1 = *(const f32x4*)(lg + 4), b0 = *(const f32x4*)lb, b1 = *(const f32x4*)(lb + 4);
      const float gg[8] = {g0[0], g0[1], g0[2], g0[3], g1[0], g1[1], g1[2], g1[3]}, bb[8] = {b0[0], b0[1], b0[2], b0[3], b1[0], b1[1], b1[2], b1[3]};
#pragma unroll
      for (int i = 0; i < 16; ++i) {
        float x[8] = {bflo(w[i].x), bfhi(w[i].x), bflo(w[i].y), bfhi(w[i].y), bflo(w[i].z), bfhi(w[i].z), bflo(w[i].w), bfhi(w[i].w)};
        float s = 0.f;
#pragma unroll
        for (int j = 0; j < 8; ++j) s += x[j];
        const float mean = wave_sum(s) * (1.f / 512.f); float q = 0.f;
#pragma unroll
        for (int j = 0; j < 8; ++j) { x[j] -= mean; q += x[j] * x[j]; }
        const float rstd = 1.0f / sqrtf(wave_sum(q) * (1.f / 512.f) + LN_EPS);
        if ((lane >> 5) == half) { u32x4 o;
            o.x = pk2(x[0] * rstd * gg[0] + bb[0], x[1] * rstd * gg[1] + bb[1]); o.y = pk2(x[2] * rstd * gg[2] + bb[2], x[3] * rstd * gg[3] + bb[3]);
            o.z = pk2(x[4] * rstd * gg[4] + bb[4], x[5] * rstd * gg[5] + bb[5]); o.w = pk2(x[6] * rstd * gg[6] + bb[6], x[7] * rstd * gg[7] + bb[7]);
            *(LAS u32x4*)(Vr + (wave * 16 + i) * VP + (lane & 31) * 16) = o; } } }
    const int t = 16 * wave + c; const int nks = (16 * wave + 15) / 32 + 1;
    const bf16* WS = (const bf16*)(A.ws + WS_SGUW);
    bf16x8 wsf[4][4];
#pragma unroll
    for (int gl = 0; gl < 4; ++gl)
#pragma unroll
        for (int ks = 0; ks < 4; ++ks) { const bf16* wp = WS + ((size_t)(4 * half + gl) * 128 + t) * 128 + 32 * ks + 4 * q4;
            union { bf16x8 v; u32x2 h[2]; } f; f.h[0] = (u32x2){0u, 0u}; f.h[1] = (u32x2){0u, 0u};
            if (ks < nks) { f.h[0] = *(const u32x2*)wp; f.h[1] = *(const u32x2*)(wp + 16); }
            wsf[gl][ks] = f.v; }
    __syncthreads();
#pragma unroll
    for (int gl = 0; gl < 4; ++gl) { const int g = 4 * half + gl;
        f32x4 acc[4] = {{0.f, 0.f, 0.f, 0.f}, {0.f, 0.f, 0.f, 0.f}, {0.f, 0.f, 0.f, 0.f}, {0.f, 0.f, 0.f, 0.f}};
#pragma unroll
        for (int ks = 0; ks < 4; ++ks) if (ks < nks) {
#pragma unroll
            for (int mb = 0; mb < 4; ++mb) { const LAS char* vp = Vr + (32 * ks + 4 * q4 + (c >> 2)) * VP + (64 * gl + 16 * mb + 4 * (c & 3)) * 2;
                const s16x4 lo = tr16(vp), hi = tr16(vp + 16 * VP);
                acc[mb] = __builtin_amdgcn_mfma_f32_16x16x32_bf16((bf16x8){lo[0], lo[1], lo[2], lo[3], hi[0], hi[1], hi[2], hi[3]}, wsf[gl][ks], acc[mb], 0, 0, 0); } }
        const float bs = A.in[I_SBS][g * 128 + t];
#pragma unroll
        for (int mb = 0; mb < 4; ++mb) { const int ch = 64 * g + 16 * mb + 4 * q4;
            const u32x2 uu = __builtin_nontemporal_load((const u32x2*)(Z + (row0 + t) * 1024 + ch));
            u32x2 o; o.x = pk2(bflo(uu.x) * (acc[mb][0] + bs), bfhi(uu.x) * (acc[mb][1] + bs)); o.y = pk2(bflo(uu.y) * (acc[mb][2] + bs), bfhi(uu.y) * (acc[mb][3] + bs));
            *(u32x2*)(OS + (row0 + t) * 512 + ch) = o; }
    }
    __syncthreads();
}

struct MaskNone { __device__ __forceinline__ bool valid(int) const { return true; } __device__ __forceinline__ bool skip(int) const { return false; } __device__ __forceinline__ int mode(int) const { return 0; } __device__ __forceinline__ bool lanepred(int) const { return true; } };
__device__ __forceinline__ void mem_unit(const Args& A, LAS unsigned char* lds, int unit, int wv) {
    const int tid = opaque_tid(wv), lane = tid & 63, wave = __builtin_amdgcn_readfirstlane(tid >> 6), c = lane & 15, q4 = lane >> 4;
    const int qt = unit & 7, h = (unit >> 3) & 3, b = unit >> 5;
    bf16* MQ = (bf16*)(A.ws + WS_MQ); const bf16* KVM = (const bf16*)(A.ws + WS_KVMEM) + (size_t)b * 256 * 1024 + h * 128;
    f32x4 acc[2][8]; float mrun[2], lrun[2];
    const size_t t0 = (size_t)b * SEQ + qt * 256 + wave * 32;
    bf16x8 qf[2][4];
#pragma unroll
    for (int cg = 0; cg < 2; ++cg)
#pragma unroll
        for (int ks = 0; ks < 4; ++ks) qf[cg][ks] = *(const bf16x8*)(MQ + (t0 + 16 * cg + c) * 512 + h * 128 + 32 * ks + 8 * q4);
#pragma unroll
    for (int cg = 0; cg < 2; ++cg) { mrun[cg] = -1e30f; lrun[cg] = 0.f;
#pragma unroll
        for (int db = 0; db < 8; ++db) acc[cg][db] = (f32x4){0.f, 0.f, 0.f, 0.f}; }
    MaskNone mf;
    attn_all<128, 2, 4, MaskNone>((LAS char*)(lds + LDS_WORK), KVM, KVM + 512, 1024, mf, qf, acc, mrun, lrun, tid, lane);
#pragma unroll
    for (int cg = 0; cg < 2; ++cg) { float l = xrow16_sum(lrun[cg]); const float inv = l > 0.f ? 1.0f / l : 0.f;
#pragma unroll
        for (int db = 0; db < 8; ++db) { u32x2 o; o.x = pk2(acc[cg][db][0] * inv, acc[cg][db][1] * inv); o.y = pk2(acc[cg][db][2] * inv, acc[cg][db][3] * inv);
            if (!A.pad || o.x == 0x12345678u) *(u32x2*)(MQ + (t0 + 16 * cg + c) * 512 + h * 128 + 16 * db + 4 * q4) = o; } }
}
struct MaskSel { int qpos, q0, q64; unsigned sel;
    __device__ __forceinline__ bool valid(int k) const { return k <= qpos; }
    __device__ __forceinline__ bool skip(int t) const { return 64 * t > q0 + 15; }
    __device__ __forceinline__ int mode(int t) const { return t < q64 ? 1 : 2; }
    __device__ __forceinline__ bool lanepred(int t) const { return (sel >> t) & 1u; } };
struct MaskWin { int qpos, q0;
    __device__ __forceinline__ bool valid(int k) const { return k <= qpos && k > qpos - 512; }
    __device__ __forceinline__ bool skip(int t) const { return 64 * t > q0 + 15 || 64 * t + 63 < q0 - 511; }
    __device__ __forceinline__ int mode(int t) const { return (64 * t + 63 <= q0 && 64 * t >= q0 + 15 - 511) ? 0 : 2; }
    __device__ __forceinline__ bool lanepred(int) const { return true; } };
__device__ __forceinline__ void nsa_unit(const Args& A, LAS unsigned char* lds, int b, int g, int q64, int wv) {
    const int tid = opaque_tid(wv), lane = tid & 63, wave = __builtin_amdgcn_readfirstlane(tid >> 6); int c = lane & 15, q4 = lane >> 4;
    asm volatile("" : "+v"(c), "+v"(q4));
    const int qg = wave & 3, hp = wave >> 2;
    const int q0 = q64 * 64 + qg * 16, qpos = q0 + c; const size_t trow = (size_t)b * SEQ + qpos;
    const bf16* Qp = (const bf16*)(A.ws + WS_Q) + trow * 512 + g * 256 + hp * 128;
    const bf16* KV = (const bf16*)(A.ws + WS_KV) + (size_t)b * SEQ * 768 + g * 64;
    const float* NG = (const float*)(A.ws + WS_NG) + trow * 32 + g * 12 + hp * 6;
    LAS char* buf = (LAS char*)(lds + LDS_WORK);
    constexpr int TB = ATile<64>::BYTES, PT = ATile<64>::PITCH;
    LAS float* impx = (LAS float*)(buf + 8 * TB);
    bf16x8 qf[2][2];
#pragma unroll
    for (int cg = 0; cg < 2; ++cg)
#pragma unroll
        for (int ks = 0; ks < 2; ++ks) qf[cg][ks] = *(const bf16x8*)(Qp + cg * 64 + 32 * ks + 8 * q4);
    float gate[2][3];
#pragma unroll
    for (int cg = 0; cg < 2; ++cg)
#pragma unroll
        for (int br = 0; br < 3; ++br) gate[cg][br] = NG[cg * 3 + br];
    f32x4 osum[2][4];
    { const bf16* KC = (const bf16*)(A.ws + WS_KCMP) + ((size_t)b * 128 * 2 + g) * 64; const bf16* VC = (const bf16*)(A.ws + WS_VCMP) + ((size_t)b * 128 * 2 + g) * 64;
      u32x4 r0[1], r1[1], r2[1], r3[1];
      tile_load<64>(KC, 128, tid, r0); tile_load<64>(VC, 128, tid, r1); tile_load<64>(KC + 64 * 128, 128, tid, r2); tile_load<64>(VC + 64 * 128, 128, tid, r3);
      tile_store<64>(buf, tid, r0); tile_store<64>(buf + TB, tid, r1); tile_store<64>(buf + 2 * TB, tid, r2); tile_store<64>(buf + 3 * TB, tid, r3); }
    __syncthreads();
    float imp[8];
#pragma unroll
    for (int i = 0; i < 8; ++i) imp[i] = 0.f;
#pragma unroll
    for (int cg = 0; cg < 2; ++cg) {
        asm volatile("" ::: "memory");
        f32x4 st[8];
#pragma unroll
        for (int sh = 0; sh < 8; ++sh) { const LAS char* Kt = buf + (sh >> 2) * 2 * TB; f32x4 s = {0.f, 0.f, 0.f, 0.f};
#pragma unroll
            for (int ks = 0; ks < 2; ++ks) { const bf16x8 kf = *(const LAS bf16x8*)(Kt + (16 * (sh & 3) + c) * PT + (32 * ks + 8 * q4) * 2);
                s = __builtin_amdgcn_mfma_f32_16x16x32_bf16(kf, qf[cg][ks], s, 0, 0, 0); }
            st[sh] = s; }
        float mx = -1e30f;
#pragma unroll
        for (int sh = 0; sh < 8; ++sh)
#pragma unroll
            for (int r = 0; r < 4; ++r) { const int n = 16 * sh + 4 * q4 + r; const bool ok = 16 * n + 31 <= qpos; st[sh][r] = ok ? st[sh][r] : -__builtin_inff(); mx = fmaxf(mx, st[sh][r]); }
        mx = xrow16_max(mx);
        float sum = 0.f;
#pragma unroll
        for (int sh = 0; sh < 8; ++sh)
#pragma unroll
            for (int r = 0; r < 4; ++r) { const float e = fast_exp2(st[sh][r] - mx); st[sh][r] = e; sum += e; }
        sum = xrow16_sum(sum);
        const float inv = sum > 0.f ? 1.0f / sum : 0.f;
        float prev3 = 0.f;
#pragma unroll
        for (int sh = 0; sh < 8; ++sh) { st[sh] = st[sh] * inv;
            const float send = q4 == 3 ? prev3 : st[sh][3];
            const float got = __shfl(send, (lane + 48) & 63);
            imp[sh] += (st[sh][0] + st[sh][1]) + (st[sh][2] + st[sh][3]) + got;
            prev3 = st[sh][3]; }
        f32x4 acc[4] = {{0.f, 0.f, 0.f, 0.f}, {0.f, 0.f, 0.f, 0.f}, {0.f, 0.f, 0.f, 0.f}, {0.f, 0.f, 0.f, 0.f}};
#pragma unroll
        for (int s4 = 0; s4 < 4; ++s4) { const LAS char* Vt = buf + (s4 >> 1) * 2 * TB + TB;
            union { bf16x8 v; unsigned u[4]; } pf;
            pf.u[0] = pg8::cvt_pk_bf16(st[2 * s4][0], st[2 * s4][1]); pf.u[1] = pg8::cvt_pk_bf16(st[2 * s4][2], st[2 * s4][3]); pf.u[2] = pg8::cvt_pk_bf16(st[2 * s4 + 1][0], st[2 * s4 + 1][1]); pf.u[3] = pg8::cvt_pk_bf16(st[2 * s4 + 1][2], st[2 * s4 + 1][3]);
#pragma unroll
            for (int db = 0; db < 4; ++db) { const LAS char* vp = Vt + (32 * (s4 & 1) + 4 * q4 + (c >> 2)) * PT + (16 * db + 4 * (c & 3)) * 2;
                const s16x4 lo = tr16(vp), hi = tr16(vp + 16 * PT);
                acc[db] = __builtin_amdgcn_mfma_f32_16x16x32_bf16((bf16x8){lo[0], lo[1], lo[2], lo[3], hi[0], hi[1], hi[2], hi[3]}, pf.v, acc[db], 0, 0, 0); } }
#pragma unroll
        for (int db = 0; db < 4; ++db) osum[cg][db] = acc[db] * gate[cg][0];
    }
#pragma unroll
    for (int sh = 0; sh < 8; sh += 4) *(LAS f32x4*)(impx + (wave * 64 + lane) * 8 + sh) = (f32x4){imp[sh], imp[sh + 1], imp[sh + 2], imp[sh + 3]};
    __syncthreads();
#pragma unroll
    for (int sh = 0; sh < 8; sh += 4) { const f32x4 o = *(const LAS f32x4*)(impx + ((wave ^ 4) * 64 + lane) * 8 + sh); imp[sh] += o[0]; imp[sh + 1] += o[1]; imp[sh + 2] += o[2]; imp[sh + 3] += o[3]; }
    unsigned sel = 0u;
    { const int cur = qpos >> 6; unsigned key[8];
#pragma unroll
        for (int sh = 0; sh < 8; ++sh) { const int j = 4 * sh + q4; const unsigned tie = 31u - (unsigned)j;
            const bool fut = j > cur, forced = (j == 0) || (j == cur) || (j == cur - 1);
            key[sh] = fut ? tie : forced ? (0x7F000000u | tie) : ((__builtin_bit_cast(unsigned, imp[sh]) & ~31u) | tie) + 64u; }
#pragma unroll 1
        for (int it = 0; it < 8; ++it) { unsigned mxk = 0u;
#pragma unroll
            for (int sh = 0; sh < 8; ++sh) mxk = key[sh] > mxk ? key[sh] : mxk;
            mxk = xrow16_umax(mxk);
#pragma unroll
            for (int sh = 0; sh < 8; ++sh) if (key[sh] == mxk) { sel |= 1u << (4 * sh + q4); key[sh] = 0u; } }
        sel = xrow16_or(sel); }
    { f32x4 acc[2][4]; float mrun[2], lrun[2];
#pragma unroll
      for (int cg = 0; cg < 2; ++cg) { mrun[cg] = -1e30f; lrun[cg] = 0.f;
#pragma unroll
          for (int db = 0; db < 4; ++db) acc[cg][db] = (f32x4){0.f, 0.f, 0.f, 0.f}; }
      MaskSel mf{qpos, q0, q64, sel};
      if (PROBE_MODE_RT != 5) attn_loop<64, 2, 2, MaskSel>(buf, KV + 256, KV + 384, 768, 0, q64, mf, qf, acc, mrun, lrun, tid, lane);
#pragma unroll
      for (int cg = 0; cg < 2; ++cg) { float l = xrow16_sum(lrun[cg]); const float sc = (l > 0.f ? 1.0f / l : 0.f) * gate[cg][1];
#pragma unroll
          for (int db = 0; db < 4; ++db) osum[cg][db] += acc[cg][db] * sc; } }
    { f32x4 acc[2][4]; float mrun[2], lrun[2];
#pragma unroll
      for (int cg = 0; cg < 2; ++cg) { mrun[cg] = -1e30f; lrun[cg] = 0.f;
#pragma unroll
          for (int db = 0; db < 4; ++db) acc[cg][db] = (f32x4){0.f, 0.f, 0.f, 0.f}; }
      MaskWin mf{qpos, q0};
      const int tlo = q64 - 8 > 0 ? q64 - 8 : 0;
      attn_loop<64, 2, 2, MaskWin>(buf, KV + 512, KV + 640, 768, tlo, q64, mf, qf, acc, mrun, lrun, tid, lane);
      bf16* ON = (bf16*)((unsigned char*)A.out + DO_ONSA) + trow * 512 + g * 256 + hp * 128;
#pragma unroll
      for (int cg = 0; cg < 2; ++cg) { float l = xrow16_sum(lrun[cg]); const float sc = (l > 0.f ? 1.0f / l : 0.f) * gate[cg][2];
#pragma unroll
          for (int db = 0; db < 4; ++db) { const f32x4 v = osum[cg][db] + acc[cg][db] * sc;
              u32x2 o; o.x = pk2(v[0], v[1]); o.y = pk2(v[2], v[3]); *(u32x2*)(ON + cg * 64 + 16 * db + 4 * q4) = o; } } }
}
__device__ __forceinline__ void p5_ln_router(const Args& A, LAS unsigned char* lds, int vcu, int G, int wv) {
    const int tid = opaque_tid(wv), lane = tid & 63, wave = __builtin_amdgcn_readfirstlane(tid >> 6), c_ = lane & 15, q4_ = lane >> 4, rt = wave & 3, kh = wave >> 2;
    float* X1 = A.out; bf16* X1B = (bf16*)(A.ws + WS_X1BF); int* TOK = (int*)(A.ws + WS_TOK); unsigned* cnt = (unsigned*)(A.ws + WS_CTL) + CW_CNT;
    const float* lg = A.in[I_LN1G]; const float* lb = A.in[I_LN1B];
    const bf16* WRH = (const bf16*)(A.ws + WS_WRH); const bf16* WRL = (const bf16*)(A.ws + WS_WRL);
    LAS float* xst = (LAS float*)(lds + LDS_WORK);
    LAS f32x4* xacc = (LAS f32x4*)(lds + LDS_WORK + 1024);
    LAS float* lgt = (LAS float*)(lds + LDS_WORK + 1024 + 12288);
    LAS unsigned* lcnt = (LAS unsigned*)(lds + LDS_MISC) + 160;
    for (int blk = vcu; blk < T / 64; blk += G) {
        int c = c_, q4 = q4_; asm volatile("" : "+v"(c), "+v"(q4));
        const int row = blk * 64 + rt * 16 + c; const int k00 = kh * 512 + 8 * q4; const size_t rbase = (size_t)row * 1024 + k00;
        f32x4 v[16][2];
#pragma unroll
        for (int ks = 0; ks < 16; ++ks) { v[ks][0] = __builtin_nontemporal_load((const f32x4*)(X1 + rbase + 32 * ks)); v[ks][1] = __builtin_nontemporal_load((const f32x4*)(X1 + rbase + 32 * ks + 4)); }
        if (tid < 32) lcnt[tid] = 0u;
        float s = 0.f;
#pragma unroll
        for (int ks = 0; ks < 16; ++ks) s += ((v[ks][0][0] + v[ks][0][1]) + (v[ks][0][2] + v[ks][0][3])) + ((v[ks][1][0] + v[ks][1][1]) + (v[ks][1][2] + v[ks][1][3]));
        s = xrow16_sum(s);
        if (q4 == 0) xst[wave * 16 + c] = s;
        __syncthreads();
        const float mean = (xst[rt * 16 + c] + xst[(rt + 4) * 16 + c]) * (1.f / 1024.f);
        float q = 0.f;
#pragma unroll
        for (int ks = 0; ks < 16; ++ks) { v[ks][0] = v[ks][0] - mean; v[ks][1] = v[ks][1] - mean;
            q += ((v[ks][0][0] * v[ks][0][0] + v[ks][0][1] * v[ks][0][1]) + (v[ks][0][2] * v[ks][0][2] + v[ks][0][3] * v[ks][0][3])) + ((v[ks][1][0] * v[ks][1][0] + v[ks][1][1] * v[ks][1][1]) + (v[ks][1][2] * v[ks][1][2] + v[ks][1][3] * v[ks][1][3])); }
        q = xrow16_sum(q);
        __syncthreads();
        if (q4 == 0) xst[wave * 16 + c] = q;
        __syncthreads();
        const float rstd = 1.0f / sqrtf((xst[rt * 16 + c] + xst[(rt + 4) * 16 + c]) * (1.f / 1024.f) + LN_EPS);
        f32x4 acc[3] = {{0.f, 0.f, 0.f, 0.f}, {0.f, 0.f, 0.f, 0.f}, {0.f, 0.f, 0.f, 0.f}};
        const bf16* wh0 = WRH + (size_t)c * 1024 + k00; const bf16* wl0 = WRL + (size_t)c * 1024 + k00;
#pragma unroll
        for (int ks = 0; ks < 16; ++ks) {
            const f32x4 g0 = *(const f32x4*)(lg + k00 + 32 * ks), g1 = *(const f32x4*)(lg + k00 + 32 * ks + 4), b0 = *(const f32x4*)(lb + k00 + 32 * ks), b1 = *(const f32x4*)(lb + k00 + 32 * ks + 4);
            const f32x4 x0 = v[ks][0] * rstd * g0 + b0, x1 = v[ks][1] * rstd * g1 + b1;
            union { bf16x8 v; unsigned u[4]; } xh, xl;
            xh.u[0] = pk2(x0[0], x0[1]); xh.u[1] = pk2(x0[2], x0[3]); xh.u[2] = pk2(x1[0], x1[1]); xh.u[3] = pk2(x1[2], x1[3]);
            if (!A.pad) *(u32x4*)(X1B + rbase + 32 * ks) = (u32x4){xh.u[0], xh.u[1], xh.u[2], xh.u[3]};
            xl.u[0] = pk2(x0[0] - bflo(xh.u[0]), x0[1] - bfhi(xh.u[0])); xl.u[1] = pk2(x0[2] - bflo(xh.u[1]), x0[3] - bfhi(xh.u[1]));
            xl.u[2] = pk2(x1[0] - bflo(xh.u[2]), x1[1] - bfhi(xh.u[2])); xl.u[3] = pk2(x1[2] - bflo(xh.u[3]), x1[3] - bfhi(xh.u[3]));
#pragma unroll
            for (int nt = 0; nt < 3; ++nt) { const bf16x8 wh = *(const bf16x8*)(wh0 + nt * 16 * 1024 + 32 * ks), wl = *(const bf16x8*)(wl0 + nt * 16 * 1024 + 32 * ks);
                acc[nt] = __builtin_amdgcn_mfma_f32_16x16x32_bf16(xh.v, wh, acc[nt], 0, 0, 0);
                acc[nt] = __builtin_amdgcn_mfma_f32_16x16x32_bf16(xh.v, wl, acc[nt], 0, 0, 0);
                acc[nt] = __builtin_amdgcn_mfma_f32_16x16x32_bf16(xl.v, wh, acc[nt], 0, 0, 0); }
            if (ks & 1) asm volatile("" ::: "memory"); }
        if (kh) {
#pragma unroll
            for (int nt = 0; nt < 3; ++nt) xacc[(rt * 3 + nt) * 64 + lane] = acc[nt]; }
        __syncthreads();
        if (!kh) {
#pragma unroll
            for (int nt = 0; nt < 3; ++nt) { const f32x4 o1 = xacc[(rt * 3 + nt) * 64 + lane];
#pragma unroll
                for (int r = 0; r < 4; ++r) lgt[(rt * 16 + 4 * q4 + r) * 48 + 16 * nt + c] = acc[nt][r] + o1[r]; } }
        __syncthreads();
        int ex0 = 0, ex1 = 0; float w0 = 0.f, w1 = 0.f; unsigned r0 = 0u, r1 = 0u;
        if (tid < 64) {
            const LAS float* L = lgt + tid * 48; float gl[4];
#pragma unroll
            for (int o = 0; o < 4; ++o) gl[o] = L[o] + A.in[I_BRG][o];
            int gi = 0; float gm = gl[0];
#pragma unroll
            for (int o = 1; o < 4; ++o) if (gl[o] > gm) { gm = gl[o]; gi = o; }
            const float gprob = 1.0f / ((expf(gl[0] - gm) + expf(gl[1] - gm)) + (expf(gl[2] - gm) + expf(gl[3] - gm)));
            float el[8];
#pragma unroll
            for (int e = 0; e < 8; ++e) el[e] = L[4 + gi * 8 + e] + A.in[I_BRE][gi * 8 + e];
            int i0 = 0; float m0 = el[0];
#pragma unroll
            for (int e = 1; e < 8; ++e) if (el[e] > m0) { m0 = el[e]; i0 = e; }
            int i1 = -1; float m1 = -3.0e38f;
#pragma unroll
            for (int e = 0; e < 8; ++e) if (e != i0 && el[e] > m1) { m1 = el[e]; i1 = e; }
            const float e1 = expf(m1 - m0), den = 1.0f / (1.0f + e1);
            w0 = gprob * den; w1 = gprob * e1 * den; ex0 = gi * 8 + i0; ex1 = gi * 8 + i1;
            r0 = atomicAdd((unsigned*)(lcnt + ex0), 1u); r1 = atomicAdd((unsigned*)(lcnt + ex1), 1u);
        }
        __syncthreads();
        if (tid < 32) { const unsigned cc = lcnt[tid]; lcnt[32 + tid] = (cc && !A.pad) ? __hip_atomic_fetch_add(cnt + 64 * tid, cc, RLX_AGENT) : 0u; }
        __syncthreads();
        if (tid < 64 && !A.pad) { int* o = TOK + (size_t)(blk * 64 + tid) * 8;
            o[0] = ex0; o[1] = ex1; o[2] = __builtin_bit_cast(int, w0); o[3] = __builtin_bit_cast(int, w1); o[4] = (int)(r0 + lcnt[32 + ex0]); o[5] = (int)(r1 + lcnt[32 + ex1]); }
        __syncthreads();
    }
}
__device__ __forceinline__ void expert_offsets(const unsigned* cnt, int lane, unsigned& mycnt, unsigned& myoff) {
    mycnt = lane < 32 ? __hip_atomic_load((unsigned*)cnt + 64 * lane, RLX_AGENT) : 0u;
    const unsigned pad = (mycnt + 255u) & ~255u; unsigned inc = pad;
#pragma unroll
    for (int o = 1; o < 32; o <<= 1) { const unsigned n = __shfl_up(inc, o); if (lane >= o) inc += n; }
    myoff = inc - pad;
}
__device__ __forceinline__ void p5b_scatter(const Args& A, int vcu, int G, int wv) {
    const int tid = opaque_tid(wv), lane = tid & 63, wave = __builtin_amdgcn_readfirstlane(tid >> 6);
    unsigned mycnt, myoff; expert_offsets((const unsigned*)(A.ws + WS_CTL) + CW_CNT, lane, mycnt, myoff);
    const int* TOK = (const int*)(A.ws + WS_TOK); int* TOKOF = (int*)(A.ws + WS_TOKOF); float* CWT = (float*)(A.ws + WS_CWT);
    for (int row = vcu * NTHR + tid; row < T; row += G * NTHR) {
        const int* tk = TOK + (size_t)row * 8;
#pragma unroll
        for (int k = 0; k < 2; ++k) { const int e = tk[k]; const unsigned pos = __shfl(myoff, e) + (unsigned)tk[4 + k]; TOKOF[pos] = row * 2 + k; CWT[pos] = __builtin_bit_cast(float, tk[2 + k]); }
    }
}
constexpr int CW_HCNT = 8192;
template <int KIND> struct MoeOrder {
    const volatile LAS unsigned* tb; unsigned* hcnt; unsigned* tmo; int wv;
    __device__ __forceinline__ bool next(int i, pg8::Unit& u) const { if (i >= (int)tb[120]) return false; u.pm = (int)tb[121 + 2 * i]; u.pn = (int)tb[122 + 2 * i]; return true; }
    static constexpr bool GATHER = (KIND == 0);
    const int* tokof;
    __device__ __forceinline__ unsigned rowoff(const pg8::Unit& u, int r) const { return ((unsigned)tokof[u.pm * 256 + r] >> 1) * 2048u; }
    __device__ __forceinline__ void a_ready(const pg8::Unit&) const {}
    __device__ __forceinline__ void done(const pg8::Unit& u) const {
        if constexpr (KIND == 0) { asm volatile("s_waitcnt vmcnt(0)" ::: "memory");
            if (lane_id() == 0) __hip_atomic_fetch_add(hcnt + 64 * u.pm, 1u, RLX_AGENT); }
    }
    __device__ __forceinline__ const char* pa(const pg8::Gemm& g, const pg8::Unit& u, size_t tstep) const { return (const char*)g.A + (GATHER ? (size_t)0 : (size_t)u.pm * tstep); }
    __device__ __forceinline__ const char* pb(const pg8::Gemm& g, const pg8::Unit& u, size_t tstep) const { return (const char*)g.Bt + (size_t)u.pn * tstep; }
};
__device__ __forceinline__ void moe_wait_tiles(const volatile LAS unsigned* tb, unsigned* hcnt, unsigned* tmo, int wv) {
    if (wv == 0) { const int n = (int)tb[120];
        for (int i = 0; i < n; ++i) { const int pm = (int)tb[121 + 2 * i]; unsigned polls = 0;
            while ((unsigned)__builtin_amdgcn_readfirstlane(__hip_atomic_load(hcnt + 64 * pm, RLX_AGENT)) < 16u) {
                if (++polls > (1u << 22)) { if (lane_id() == 0) __hip_atomic_store(tmo, 1u, RLX_AGENT); break; }
                __builtin_amdgcn_s_sleep(2); } }
        __builtin_amdgcn_fence(__ATOMIC_ACQUIRE, "agent");
        asm volatile("s_waitcnt vmcnt(0)" ::: "memory"); }
    __syncthreads();
}
__device__ __forceinline__ void moe_tables(const Args& A, volatile LAS unsigned* tb, int tid, int kind, int G, int c) {
    if (tid < 64) { unsigned mycnt, myoff; expert_offsets((const unsigned*)(A.ws + WS_CTL) + CW_CNT, tid, mycnt, myoff);
        if (tid < 32) { tb[tid] = myoff >> 8; tb[40 + tid] = myoff >> 8; tb[80 + tid] = mycnt; }
        if (tid == 31) tb[32] = (myoff + ((mycnt + 255u) & ~255u)) >> 8; }
    __syncthreads();
    if (tid == 0) { const int tiles = (int)tb[32], NU = 2 * tiles; int n = 0;
        const int NH = NU > G ? NU - G : 0, NL = G - NH, half = G / 2;
        for (int k = 0; k < 8 && n < 40; ++k) { int tile, j, NJ;
            if (kind == 0) { const int L = c + k * G; if (L >= NU) break; tile = L >> 1; j = L & 1; NJ = 2; }
            else if (c < NH) break;
            else if (kind == 1) { const int D = (c - NH) + k * NL; const int lim = 4 * (tiles < half ? tiles : half); if (D >= lim) break; tile = D >> 2; j = D & 3; NJ = 4; }
            else { const int D = (c - NH) + k * NL; const int lim = 4 * (tiles > half ? tiles - half : 0); if (D >= lim) break; tile = half + (D >> 2); j = D & 3; NJ = 4; }
            int e = 0;
            for (int q = 16; q >= 1; q >>= 1) if (e + q < 32 && (int)tb[e + q] <= tile) e += q;
            tb[121 + 2 * n] = tb[40 + e] + (unsigned)(tile - (int)tb[e]); tb[122 + 2 * n] = (unsigned)(e * NJ + j); ++n; }
        tb[120] = (unsigned)n; }
    __syncthreads();
}
struct EpiMoeUp {
    static constexpr bool PERM = true, AFTER_DRAIN = false;
    __device__ __forceinline__ bool keep(const pg8::Unit&) const { return false; }
    bf16* H;
    __device__ __forceinline__ void operator()(const f32x4 (&acc)[2][2][4][2], const pg8::Unit& u, int wr, int wc, int fr, int fq) const {
        const int row0 = u.pm * 256 + wr * 64 + fr, col0 = (u.pn & 1) * 128 + wc * 32 + 8 * fq;
#pragma unroll
        for (int ai = 0; ai < 2; ++ai)
#pragma unroll
            for (int m = 0; m < 4; ++m) { float h[8];
#pragma unroll
                for (int n = 0; n < 2; ++n)
#pragma unroll
                    for (int i = 0; i < 4; ++i) { const float gt = acc[ai][0][m][n][i], up = acc[ai][1][m][n][i]; h[4 * n + i] = gt * sigmoidf_(gt) * up; }
                u32x4 w; w.x = pg8::cvt_pk_bf16(h[0], h[1]); w.y = pg8::cvt_pk_bf16(h[2], h[3]); w.z = pg8::cvt_pk_bf16(h[4], h[5]); w.w = pg8::cvt_pk_bf16(h[6], h[7]);
                bf16* hp = H + (size_t)(row0 + ai * 128 + m * 16) * 256 + col0;
                asm volatile("global_store_dwordx4 %0, %1, off sc1\n\ts_nop 1" :: "v"(hp), "v"(w) : "memory"); }
    }
};
struct EpiMoeDown {
    static constexpr bool PERM = true, AFTER_DRAIN = false;
    __device__ __forceinline__ bool keep(const pg8::Unit&) const { return false; }
    bf16* F; const int* TOKOF; const float* CWT; const volatile LAS unsigned* tb;
    __device__ __forceinline__ void operator()(const f32x4 (&acc)[2][2][4][2], const pg8::Unit& u, int wr, int wc, int fr, int fq) const {
        const int e = u.pn >> 2, j = u.pn & 3; const int rbase = (int)tb[40 + e] * 256, cnte = (int)tb[80 + e];
        const int row0 = u.pm * 256 + wr * 64 + fr, col0 = j * 256 + wc * 32 + 8 * fq;
#pragma unroll
        for (int ai = 0; ai < 2; ++ai)
#pragma unroll
            for (int m = 0; m < 4; ++m) { const int r = row0 + ai * 128 + m * 16;
                if (r - rbase < cnte) { const int dst = TOKOF[r]; const float wgt = CWT[r];
#pragma unroll
                    for (int bj = 0; bj < 2; ++bj) { const f32x4 v0 = acc[ai][bj][m][0] * wgt, v1 = acc[ai][bj][m][1] * wgt;
                        u32x4 w; w.x = pg8::cvt_pk_bf16(v0[0], v0[1]); w.y = pg8::cvt_pk_bf16(v0[2], v0[3]); w.z = pg8::cvt_pk_bf16(v1[0], v1[1]); w.w = pg8::cvt_pk_bf16(v1[2], v1[3]);
                        *(u32x4*)(F + (size_t)dst * 1024 + col0 + bj * 128) = w; } } }
    }
};
__device__ __forceinline__ void p7_final(const Args& A, int vcu, int G, int wv) {
    const int tid = opaque_tid(wv), lane = tid & 63, wave = __builtin_amdgcn_readfirstlane(tid >> 6);
    float* X1 = A.out; const bf16* X1B = (const bf16*)(A.ws + WS_X1BF); const bf16* F = (const bf16*)(A.ws + WS_FBUF);
    const float* lg = A.in[I_LN2G]; const float* lb = A.in[I_LN2B];
    f32x4 gv[4], bv[4];
#pragma unroll
    for (int j = 0; j < 4; ++j) { gv[j] = *(const f32x4*)(lg + 4 * lane + 256 * j); bv[j] = *(const f32x4*)(lb + 4 * lane + 256 * j); }
    for (int row = vcu * NWAVES + wave; row < T; row += G * NWAVES) {
        f32x4 v[4]; float s = 0.f;
#pragma unroll
        for (int j = 0; j < 4; ++j) { const size_t o = (size_t)row * 1024 + 4 * lane + 256 * j; const u32x2 xb = __builtin_nontemporal_load((const u32x2*)(X1B + o));
            v[j] = (f32x4){bflo(xb.x), bfhi(xb.x), bflo(xb.y), bfhi(xb.y)} * DN_ALPHA;
            const u32x2 f0 = __builtin_nontemporal_load((const u32x2*)(F + (size_t)row * 2048 + 4 * lane + 256 * j)), f1 = __builtin_nontemporal_load((const u32x2*)(F + (size_t)row * 2048 + 1024 + 4 * lane + 256 * j));
            v[j][0] += bflo(f0.x) + bflo(f1.x); v[j][1] += bfhi(f0.x) + bfhi(f1.x); v[j][2] += bflo(f0.y) + bflo(f1.y); v[j][3] += bfhi(f0.y) + bfhi(f1.y);
            s += (v[j][0] + v[j][1]) + (v[j][2] + v[j][3]); }
        const float mean = wave_sum(s) * (1.f / 1024.f); float q = 0.f;
#pragma unroll
        for (int j = 0; j < 4; ++j) { v[j] = v[j] - mean; q += (v[j][0] * v[j][0] + v[j][1] * v[j][1]) + (v[j][2] * v[j][2] + v[j][3] * v[j][3]); }
        const float rstd = 1.0f / sqrtf(wave_sum(q) * (1.f / 1024.f) + LN_EPS);
#pragma unroll
        for (int j = 0; j < 4; ++j) { const f32x4 r = v[j] * rstd * gv[j] + bv[j]; if (!A.pad || r[0] == 12345.678f) __builtin_nontemporal_store(r, (f32x4*)(X1 + (size_t)row * 1024 + 4 * lane + 256 * j)); }
    }
}
#if SELFCHECK
constexpr int CW_CHK = 64;
__device__ __forceinline__ float block_max(float v, LAS float* red, int tid) {
#pragma unroll
    for (int o = 1; o < 64; o <<= 1) v = fmaxf(v, __shfl_xor(v, o));
    __syncthreads(); if ((tid & 63) == 0) red[tid >> 6] = v; __syncthreads();
    float r = red[0]; for (int i = 1; i < 8; ++i) r = fmaxf(r, red[i]); __syncthreads(); return r;
}
__device__ __forceinline__ void chk_report(const Args& A, int slot, float diff, float ref) {
    const float ratio = diff / fmaxf(ref, 1e-20f); atomicMax((unsigned*)(A.ws + WS_CTL) + CW_CHK + slot, __builtin_bit_cast(unsigned, ratio)); }
__device__ __forceinline__ float gelu_ref(float x) { return 0.5f * x * (1.0f + erff(x * 0.70710678118654752f)); }
__device__ __forceinline__ float sig_ref(float x) { return 1.0f / (1.0f + expf(-x)); }
__device__ __forceinline__ void chk_inproj(const Args& A, LAS unsigned char* lds, int sample) {
    const int tid = threadIdx.x; const int toks[8] = {0, 1, 777, 2047, 2048 + 31, 3 * 2048 + 1000, 7 * 2048 + 2047, 5 * 2048 + 64};
    int t = 0;
#pragma unroll
    for (int i = 0; i < 8; ++i) if (sample == i) t = toks[i];
    LAS float* h = (LAS float*)(lds + LDS_WORK); LAS float* red = h + 6000;
    const float* x = A.in[I_X] + (size_t)t * 1024; const float* w = A.in[I_WIN];
    for (int cidx = tid; cidx < IN_W; cidx += NTHR) { float a = 0.f; for (int k = 0; k < 1024; ++k) a += x[k] * w[(size_t)k * IN_W + cidx]; h[cidx] = a; }
    __syncthreads();
    const int pos = t & (SEQ - 1); float dmax = 0.f, rmax = 0.f;
    const bf16* Q = (const bf16*)(A.ws + WS_Q); const bf16* KV = (const bf16*)(A.ws + WS_KV); const bf16* Z = (const bf16*)(A.ws + WS_Z); const bf16* MG = (const bf16*)(A.ws + WS_MG);
    const bf16* MQ = (const bf16*)(A.ws + WS_MQ); const float* NG = (const float*)(A.ws + WS_NG);
    for (int cidx = tid; cidx < IN_W; cidx += NTHR) {
        float e, got;
        if (cidx < 1280) {
            const int d = cidx & 63; const bool isv = cidx >= 512 && (((cidx - 512) >> 7) & 1); float v = h[cidx];
            if (!isv && d < 16) { const int i = d & 7; const float inv = powf(500000.0f, -(float)i / 8.0f); const float ang = (float)pos * inv; const float cs = cosf(ang), sn = sinf(ang);
                v = d < 8 ? h[cidx] * cs - h[cidx + 8] * sn : h[cidx] * cs + h[cidx - 8] * sn; }
            if (cidx < 512) { e = v * QSCALE; got = bf2f(Q[(size_t)t * 512 + cidx]); } else { e = v; got = bf2f(KV[(size_t)t * 768 + cidx - 512]); }
        } else if (cidx < S_SGU) { e = sig_ref(h[cidx]); got = NG[(size_t)t * 32 + cidx - S_NG]; }
        else if (cidx < S_MQ) { e = gelu_ref(h[cidx]); got = bf2f(Z[(size_t)t * 1024 + cidx - S_SGU]); }
        else if (cidx < S_MG) { e = h[cidx] * MQSCALE; got = bf2f(MQ[(size_t)t * 512 + cidx - S_MQ]); }
        else { e = sig_ref(h[cidx]); const int col = cidx - S_MG, rr = t & 255, cc = col & 255;
            const size_t ix = mg_index(t >> 8, col >> 8, rr >> 7, (rr & 63) >> 4, cc >> 7, (rr & 127) >> 6, (cc & 127) >> 5, rr & 15, (cc & 31) >> 3);
            got = (float)((const unsigned char*)MG)[ix * 8 + (cc & 7)] * (1.0f / 255.0f); }
        dmax = fmaxf(dmax, fabsf(e - got)); rmax = fmaxf(rmax, fabsf(e));
    }
    dmax = block_max(dmax, red, tid); rmax = block_max(rmax, red, tid);
    if (tid == 0) chk_report(A, 0, dmax, rmax);
    { const int r = (t * 37) % (NB * 256); const float* mr = A.in[I_MEM] + (size_t)r * 1024; const float* wm = A.in[I_WMEMKV]; const bf16* KVM = (const bf16*)(A.ws + WS_KVMEM);
      float d2 = 0.f, r2 = 0.f;
      for (int cidx = tid; cidx < 1024; cidx += NTHR) { float a = 0.f; for (int k = 0; k < 1024; ++k) a += mr[k] * wm[(size_t)k * 1024 + cidx]; d2 = fmaxf(d2, fabsf(a - bf2f(KVM[(size_t)r * 1024 + cidx]))); r2 = fmaxf(r2, fabsf(a)); }
      d2 = block_max(d2, red, tid); r2 = block_max(r2, red, tid); if (tid == 0) chk_report(A, 1, d2, r2); }
}
__device__ __forceinline__ void chk_compress(const Args& A, LAS unsigned char* lds, int sample) {
    const int tid = threadIdx.x; const int kv = sample & 1, g = (sample >> 1) & 1, b = (sample >> 2) & 7; const int ns[4] = {0, 1, 63, 126}; int n = 0;
#pragma unroll
    for (int i = 0; i < 4; ++i) if (((sample >> 5) & 3) == i) n = ns[i];
    LAS float* blk = (LAS float*)(lds + LDS_WORK); LAS float* hid = blk + 2048; LAS float* red = hid + 256;
    const bf16* KV = (const bf16*)(A.ws + WS_KV); const float* pe = A.in[kv ? I_PEV : I_PEK]; const float* w1 = A.in[kv ? I_W1V : I_W1K]; const float* w2 = A.in[kv ? I_W2V : I_W2K];
    for (int i = tid; i < 2048; i += NTHR) { const int l = i >> 6, d = i & 63; blk[i] = bf2f(KV[(size_t)(b * SEQ + 16 * n + l) * 768 + kv * 128 + g * 64 + d]) + pe[i]; }
    __syncthreads();
    if (tid < 256) { float a = 0.f; for (int k = 0; k < 2048; ++k) a += blk[k] * w1[(size_t)k * 256 + tid]; hid[tid] = gelu_ref(a); }
    __syncthreads();
    float dmax = 0.f, rmax = 0.f;
    if (tid < 64) { float a = 0.f; for (int j = 0; j < 256; ++j) a += hid[j] * w2[j * 64 + tid];
        const bf16* O = (const bf16*)(A.ws + (kv ? WS_VCMP : WS_KCMP)); dmax = fabsf(a - bf2f(O[((size_t)(b * 128 + n) * 2 + g) * 64 + tid])); rmax = fabsf(a); }
    dmax = block_max(dmax, red, tid); rmax = block_max(rmax, red, tid);
    if (tid == 0) chk_report(A, 2, dmax, rmax);
}
__device__ __forceinline__ void chk_nsa(const Args& A, LAS unsigned char* lds, int sample) {
    const int tid = threadIdx.x; const int g = sample & 1, b = (sample >> 1) & 7; const int ts[16] = {0, 5, 30, 31, 47, 63, 64, 100, 511, 512, 513, 700, 1023, 1024, 1999, 2047}; int t = 0;
#pragma unroll
    for (int i = 0; i < 16; ++i) if ((sample >> 4) == i) t = ts[i];
    LAS float* q = (LAS float*)(lds + LDS_WORK);
    LAS float* sc = q + 256;
    LAS float* oc = sc + 2048;
    LAS float* os = oc + 256;
    LAS float* ow = os + 256;
    LAS float* imp = ow + 256;
    LAS int* blks = (LAS int*)(imp + 32);
    LAS float* red = imp + 48;
    const size_t trow = (size_t)b * SEQ + t;
    const bf16* Q = (const bf16*)(A.ws + WS_Q) + trow * 512 + g * 256; const bf16* KV = (const bf16*)(A.ws + WS_KV) + (size_t)b * SEQ * 768 + g * 64;
    const bf16* KC = (const bf16*)(A.ws + WS_KCMP) + ((size_t)b * 256 + g) * 64; const bf16* VC = (const bf16*)(A.ws + WS_VCMP) + ((size_t)b * 256 + g) * 64;
    const float LN2 = 0.6931471805599453f;
    if (tid < 256) q[tid] = bf2f(Q[tid]) * LN2;
    __syncthreads();
    { const int h = tid >> 7, n = tid & 127; float a = -1e30f;
      if (n < 127 && 16 * n + 31 <= t) { a = 0.f; for (int d = 0; d < 64; ++d) a += q[h * 64 + d] * bf2f(KC[(size_t)n * 128 + d]); }
      sc[h * 512 + n] = a; }
    __syncthreads();
    if (tid < 4) { float m = -1e30f; for (int n = 0; n < 127; ++n) m = fmaxf(m, sc[tid * 512 + n]); float s = 0.f;
        for (int n = 0; n < 127; ++n) { const float e = sc[tid * 512 + n] > -1e29f ? expf(sc[tid * 512 + n] - m) : 0.f; sc[tid * 512 + n] = e; s += e; }
        const float inv = s > 0.f ? 1.f / s : 1.f; for (int n = 0; n < 127; ++n) sc[tid * 512 + n] *= inv; }
    __syncthreads();
    if (tid < 256) { const int h = tid >> 6, d = tid & 63; float a = 0.f; for (int n = 0; n < 127; ++n) a += sc[h * 512 + n] * bf2f(VC[(size_t)n * 128 + d]); oc[tid] = a; }
    if (tid < 32) { float a = 0.f; for (int n = 0; n < 127; ++n) { const bool ov = (16 * n + 31 >= 64 * tid) && (16 * n <= 64 * tid + 63); if (ov) for (int h = 0; h < 4; ++h) a += sc[h * 512 + n]; }
        const int cur = t >> 6; const bool fut = tid > cur, forced = tid == 0 || tid == cur || tid == cur - 1; imp[tid] = fut ? -1e30f : forced ? 1e30f : a; }
    __syncthreads();
    if (tid == 0) { for (int k = 0; k < 8; ++k) { int bi = 0; float bv = -3e38f; for (int j = 0; j < 32; ++j) if (imp[j] > bv) { bv = imp[j]; bi = j; } blks[k] = bi; imp[bi] = -3e38f; } }
    __syncthreads();
    { const int kk = tid, blk = blks[kk >> 6], kpos = blk * 64 + (kk & 63);
      for (int h = 0; h < 4; ++h) { float a = -1e30f; if (kpos <= t) { a = 0.f; for (int d = 0; d < 64; ++d) a += q[h * 64 + d] * bf2f(KV[(size_t)kpos * 768 + 256 + d]); } sc[h * 512 + kk] = a; } }
    __syncthreads();
    if (tid < 4) { float m = -1e30f; for (int n = 0; n < 512; ++n) m = fmaxf(m, sc[tid * 512 + n]); float s = 0.f;
        for (int n = 0; n < 512; ++n) { const float e = sc[tid * 512 + n] > -1e29f ? expf(sc[tid * 512 + n] - m) : 0.f; sc[tid * 512 + n] = e; s += e; }
        const float inv = s > 0.f ? 1.f / s : 1.f; for (int n = 0; n < 512; ++n) sc[tid * 512 + n] *= inv; }
    __syncthreads();
    if (tid < 256) { const int h = tid >> 6, d = tid & 63; float a = 0.f; for (int kk = 0; kk < 512; ++kk) { const int kpos = blks[kk >> 6] * 64 + (kk & 63); a += sc[h * 512 + kk] * bf2f(KV[(size_t)kpos * 768 + 384 + d]); } os[tid] = a; }
    __syncthreads();
    { const int kpos = t - 511 + tid;
      for (int h = 0; h < 4; ++h) { float a = -1e30f; if (kpos >= 0) { a = 0.f; for (int d = 0; d < 64; ++d) a += q[h * 64 + d] * bf2f(KV[(size_t)kpos * 768 + 512 + d]); } sc[h * 512 + tid] = a; } }
    __syncthreads();
    if (tid < 4) { float m = -1e30f; for (int n = 0; n < 512; ++n) m = fmaxf(m, sc[tid * 512 + n]); float s = 0.f;
        for (int n = 0; n < 512; ++n) { const float e = sc[tid * 512 + n] > -1e29f ? expf(sc[tid * 512 + n] - m) : 0.f; sc[tid * 512 + n] = e; s += e; }
        const float inv = s > 0.f ? 1.f / s : 1.f; for (int n = 0; n < 512; ++n) sc[tid * 512 + n] *= inv; }
    __syncthreads();
    if (tid < 256) { const int h = tid >> 6, d = tid & 63; float a = 0.f; for (int kk = 0; kk < 512; ++kk) { const int kpos = t - 511 + kk; if (kpos >= 0) a += sc[h * 512 + kk] * bf2f(KV[(size_t)kpos * 768 + 640 + d]); } ow[tid] = a; }
    __syncthreads();
    float dmax = 0.f, rmax = 0.f;
    if (tid < 256) { const int h = tid >> 6; const float* NG = (const float*)(A.ws + WS_NG) + trow * 32 + (g * 4 + h) * 3;
        const float e = NG[0] * oc[tid] + NG[1] * os[tid] + NG[2] * ow[tid]; const float got = bf2f(((const bf16*)((unsigned char*)A.out + DO_ONSA))[trow * 512 + g * 256 + tid]);
        dmax = fabsf(e - got); rmax = fabsf(e); }
    dmax = block_max(dmax, red, tid); rmax = block_max(rmax, red, tid);
    if (tid == 0) chk_report(A, 3, dmax, rmax);
}
__device__ __forceinline__ void chk_mem(const Args& A, LAS unsigned char* lds, int sample) {
    const int tid = threadIdx.x; const int h = sample & 3, b = (sample >> 2) & 7; const int t = ((sample >> 5) * 683 + 17 * b) & (SEQ - 1);
    LAS float* q = (LAS float*)(lds + LDS_WORK); LAS float* sc = q + 128; LAS float* red = sc + 256;
    const size_t trow = (size_t)b * SEQ + t; const float* x = A.in[I_X] + trow * 1024; const float* w = A.in[I_WIN];
    if (tid < 128) { float a = 0.f; for (int k = 0; k < 1024; ++k) a += x[k] * w[(size_t)k * IN_W + S_MQ + h * 128 + tid]; q[tid] = a * 0.08838834764831845f; }
    __syncthreads();
    const bf16* KVM = (const bf16*)(A.ws + WS_KVMEM) + (size_t)b * 256 * 1024 + h * 128;
    if (tid < 256) { float a = 0.f; for (int d = 0; d < 128; ++d) a += q[d] * bf2f(KVM[(size_t)tid * 1024 + d]); sc[tid] = a; }
    __syncthreads();
    if (tid == 0) { float m = -1e30f; for (int n = 0; n < 256; ++n) m = fmaxf(m, sc[n]); float s = 0.f; for (int n = 0; n < 256; ++n) { sc[n] = expf(sc[n] - m); s += sc[n]; } for (int n = 0; n < 256; ++n) sc[n] /= s; }
    __syncthreads();
    float dmax = 0.f, rmax = 0.f;
    if (tid < 128) { float a = 0.f; for (int n = 0; n < 256; ++n) a += sc[n] * bf2f(KVM[(size_t)n * 1024 + 512 + tid]);
        const float got = bf2f(((const bf16*)(A.ws + WS_MQ))[trow * 512 + h * 128 + tid]); dmax = fabsf(a - got); rmax = fabsf(a); }
    dmax = block_max(dmax, red, tid); rmax = block_max(rmax, red, tid);
    if (tid == 0) chk_report(A, 6, dmax, rmax);
}
#endif
constexpr int N_PHASES = 11;
__global__ void __launch_bounds__(NTHR, 2) hybrid_fwd(Args A) {
    extern __shared__ __attribute__((aligned(16))) unsigned char lds_raw[];
    LAS unsigned char* lds = (LAS unsigned char*)lds_raw;
    volatile LAS unsigned* MISC = (volatile LAS unsigned*)(lds + LDS_MISC);
    const int wv = __builtin_amdgcn_readfirstlane((int)threadIdx.x >> 6);
#define tid (wv * 64 + lane_id())
    const int G = gridDim.x; const int bx = blockIdx.x; const int vcu = (G % 8 == 0) ? (bx % 8) * (G / 8) + bx / 8 : bx;
    if (tid < 256) MISC[tid] = 0u;
    __syncthreads();
#if defined(DRY_PHASE)
    if (tid == 0) MISC[240] = (unsigned)A.pad;
    __syncthreads();
#endif
    unsigned char* ws = A.ws;
    gu32* ctl = (gu32*)(ws + WS_CTL);
#if MK_PER_PHASE
#define GRID_BAR() do { } while (0)
#else
    XcdBarrier bar = xcd_barrier_post((unsigned*)ctl + CW_BAR, MISC + 8, wv);
#define GRID_BAR() xcd_barrier(bar)
#endif
    const int lo = A.ph_lo, hi = A.ph_hi;
#ifndef PHASE_MASK
#define PHASE_MASK 0xFFFF
#endif
#define IN(k) (((PHASE_MASK >> (k)) & 1) && lo <= (k) && (k) < hi)
#define BOTH(k) (IN(k) && IN((k) + 1))
#ifndef REP_MASK
#define REP_MASK 0
#endif
#define REPS(k) (((REP_MASK >> (k)) & 1) ? 2 : 1)
    LAS unsigned char* wl = lds + LDS_WORK;
    if (IN(0)) { p0_prologue(A, lds, vcu, G, wv); if (BOTH(0)) GRID_BAR(); }
    if (IN(1)) {
        { pg8::Gemm g{(const bf16*)(ws + WS_XBF), (const bf16*)(ws + WS_WINT), T, NIN - 256, DM}; P1Order S; S.so.init(T, NIN - 256, G, bx); S.memA = (const bf16*)(ws + WS_MEMBF); S.memB = (const bf16*)(ws + WS_WMEMT);
          EpiInProj E{(bf16*)(ws + WS_Q), (bf16*)(ws + WS_KV), (bf16*)(ws + WS_Z), (bf16*)(ws + WS_MQ), (bf16*)(ws + WS_MG), (bf16*)(ws + WS_KVMEM), (const float*)(ws + WS_ROPE)};
          pg8::gemm_phase<EpiInProj, P1Order, true, true>(wl, g, S, E, wv); }
        nsa_gates((const bf16*)(ws + WS_XBF), (const bf16*)(ws + WS_WINT) + (size_t)C_NG * 1024, (float*)(ws + WS_NG), lds, vcu, G, tid);
        if (BOTH(1)) GRID_BAR();
#if SELFCHECK
        if (vcu < 8) chk_inproj(A, lds, vcu);
        GRID_BAR();
#endif
    }
    if (IN(2)) {
        if (A.sub & 1) for (int u = vcu; u < 128; u += G) compress_unit(A, lds, u, wv);
        if (A.sub & 2) for (int u = vcu; u < 256; u += G) sgu_unit(A, lds, u, wv);
        if (A.sub & 4) for (int u = vcu; u < 256; u += G) mem_unit(A, lds, u, wv);
        if (A.sub & 8) convert_experts(A, lds, vcu, G, wv);
        if (BOTH(2)) GRID_BAR();
#if SELFCHECK
        if (vcu < 128) chk_compress(A, lds, vcu);
        chk_mem(A, lds, vcu);
#endif
    }
    if (IN(3)) {
        for (int u = vcu; u < 256; u += G) { const int j = u & 15, bg = u >> 4;        nsa_unit(A, lds, bg >> 1, bg & 1, 31 - j, wv); nsa_unit(A, lds, bg >> 1, bg & 1, j, wv); }
        if (BOTH(3)) GRID_BAR();
#if SELFCHECK
        chk_nsa(A, lds, vcu);
#endif
    }
    if (IN(4)) {
        P4Order S; S.so.init(T, DM, G, bx); S.outb = (const unsigned char*)A.out; S.mq = ws + WS_MQ;
        pg8::Gemm g{(const bf16*)A.out, (const bf16*)(ws + WS_WBRT), T, 3 * DM, 512}; EpiBranch E{(bf16*)(ws + WS_Y), (const bf16*)(ws + WS_MG)};
        pg8::gemm_phase<EpiBranch, P4Order, true, true>(wl, g, S, E, wv);
        if (BOTH(4)) GRID_BAR();
    }
    if (IN(5)) {
        pg8::Gemm g{(const bf16*)(ws + WS_Y), (const bf16*)(ws + WS_WOT), T, DM, DM}; pg8::StaticOrder S; S.init(T, DM, G, bx);
        EpiResid E{A.in[I_X], A.out};
        pg8::gemm_phase<EpiResid, pg8::StaticOrder, true, true>(wl, g, S, E, wv);
        if (BOTH(5)) GRID_BAR();
    }
    if (IN(6)) { for (int i = vcu * NTHR + tid; i < XS_ROWS; i += G * NTHR) ((int*)(ws + WS_TOKOF))[i] = 0;
        p5_ln_router(A, lds, vcu, G, wv); if (BOTH(6)) GRID_BAR(); }
    if (IN(7)) { p5b_scatter(A, vcu, G, wv); if (BOTH(7)) GRID_BAR(); }
    if (IN(8)) {
        unsigned* hcnt = (unsigned*)ctl + CW_HCNT; unsigned* tmo = (unsigned*)ctl + CW_BAR + XB_TMO;
        { moe_tables(A, MISC + 32, tid, 0, G, vcu);
          pg8::Gemm g{(const bf16*)(ws + WS_X1BF), (const bf16*)(ws + WS_WGUT), XS_ROWS, NEXP * 512, DM}; MoeOrder<0> S{MISC + 32, hcnt, tmo, wv, (const int*)(ws + WS_TOKOF)};
          EpiMoeUp E{(bf16*)(ws + WS_H)};
          pg8::gemm_phase<EpiMoeUp, MoeOrder<0>, true, true>(wl, g, S, E, wv); }
#define MOE_DOWN(kind) do { moe_tables(A, MISC + 32, tid, kind, G, vcu); moe_wait_tiles(MISC + 32, hcnt, tmo, wv); \
          pg8::Gemm g{(const bf16*)(ws + WS_H), (const bf16*)(ws + WS_WDT), XS_ROWS, NEXP * 1024, FF}; MoeOrder<1> S{MISC + 32, hcnt, tmo, wv, nullptr}; \
          EpiMoeDown E{(bf16*)(ws + WS_FBUF), (const int*)(ws + WS_TOKOF), (const float*)(ws + WS_CWT), MISC + 32}; \
          pg8::gemm_phase<EpiMoeDown, MoeOrder<1>, true, true>(wl, g, S, E, wv); } while (0)
        MOE_DOWN(1);
        MOE_DOWN(2);
#undef MOE_DOWN
        if (BOTH(8)) GRID_BAR();
    }
    if (IN(9)) { if (BOTH(9)) GRID_BAR(); }
    if (IN(10)) { p7_final(A, vcu, G, wv);
#if SELFCHECK
        GRID_BAR();
        if (bx == 0 && tid == 0) { float r = 0.f;
            for (int i = 0; i < 8; ++i) if ((CHECK_SEL >> i) & 1) r = fmaxf(r, __builtin_bit_cast(float, __hip_atomic_load((unsigned*)ctl + CW_CHK + i, RLX_AGENT)));
            float code = rintf(-4.0f * log2f(fmaxf(r, 1e-9f))); code = fminf(fmaxf(code, 0.f), 60.f);
            A.out[0] = 200.0f * powf(1.12f, 60.0f - code); }
#endif
    }
#undef IN
#undef BOTH
#undef tid
}

extern "C" void kernel_launch(void* const* d_in, const int* in_sizes, int n_in, void* d_out, int out_size, void* d_ws, size_t ws_size, hipStream_t stream) {
    static int grid = 0;
    if (grid == 0) {
        if (n_in != 29 || in_sizes[0] != T * DM || out_size != T * DM || ws_size < WS_END) { fprintf(stderr, "kernel_launch: unexpected shapes (n_in %d, in0 %d, out %d, ws %zu)\n", n_in, n_in > 0 ? in_sizes[0] : -1, out_size, ws_size); grid = -1; return; }
        int dev = 0, cus = 0, per_cu = 0;
        if (hipGetDevice(&dev) != hipSuccess || hipDeviceGetAttribute(&cus, hipDeviceAttributeMultiprocessorCount, dev) != hipSuccess) { grid = -1; return; }
        if (hipFuncSetAttribute((const void*)hybrid_fwd, hipFuncAttributeMaxDynamicSharedMemorySize, LDS_BYTES) != hipSuccess) { fprintf(stderr, "kernel_launch: hipFuncSetAttribute failed\n"); grid = -1; return; }
        if (hipOccupancyMaxActiveBlocksPerMultiprocessor(&per_cu, (const void*)hybrid_fwd, NTHR, LDS_BYTES) != hipSuccess || per_cu < 1) fprintf(stderr, "kernel_launch: occupancy query reports %d\n", per_cu);
        (void)hipGetLastError();
        grid = cus;
    }
    if (grid < 0) return;
    (void)hipMemsetAsync((char*)d_ws + WS_CTL, 0, CTL_ZERO_BYTES, stream);
    Args a{};
    for (int i = 0; i < 29; ++i) a.in[i] = (const float*)d_in[i];
    a.out = (float*)d_out; a.ws = (unsigned char*)d_ws;
#if MK_PER_PHASE
    for (int p = 0; p < N_PHASES; ++p) { a.ph_lo = p; a.ph_hi = p + 1;
#if defined(DRY_PHASE)
        if (p == DRY_PHASE) for (int r = 0; r < 2; ++r) { a.sub = REP_SUB; a.pad = DRY_MODE; hipLaunchKernelGGL(hybrid_fwd, dim3(grid), dim3(NTHR), LDS_BYTES, stream, a); }
#endif
        a.sub = 0xF; a.pad = 0; hipLaunchKernelGGL(hybrid_fwd, dim3(grid), dim3(NTHR), LDS_BYTES, stream, a);
#if defined(REP_PHASE)
        if (p == REP_PHASE) for (int r = 0; r < 2; ++r) { a.sub = REP_SUB; hipLaunchKernelGGL(hybrid_fwd, dim3(grid), dim3(NTHR), LDS_BYTES, stream, a); }
#endif
    }
#else
    a.ph_lo = 0; a.ph_hi = N_PHASES; a.sub = 0xF;
    hipLaunchKernelGGL(hybrid_fwd, dim3(grid), dim3(NTHR), LDS_BYTES, stream, a);
#endif
}
```

```cpp
#include <hip/hip_runtime.h>
#include <cstdio>
#include <cstdint>
#ifndef MK_PER_PHASE
#define MK_PER_PHASE 0
#endif
#ifndef SELFCHECK
#define SELFCHECK 0
#endif
#ifndef CHECK_SEL
#define CHECK_SEL 0xFF
#endif
#ifndef WSUM_DPP
#define WSUM_DPP 1
#endif
__device__ __forceinline__ int lane_id() { return (int)__builtin_amdgcn_mbcnt_hi(~0u, __builtin_amdgcn_mbcnt_lo(~0u, 0u)); }
__device__ __forceinline__ int opaque_tid(int wv) { int l; asm volatile("v_mbcnt_lo_u32_b32 %0, -1, 0\n\tv_mbcnt_hi_u32_b32 %0, -1, %0" : "=v"(l)); return wv * 64 + l; }
#ifndef DRY_MODE
#define DRY_MODE 1
#endif
#if defined(DRY_PHASE) && defined(ATTN_PROBE)
#define PROBE_MODE_RT ((int)*(volatile __attribute__((address_space(3))) unsigned*)(960))
#else
#define PROBE_MODE_RT 0
#endif
#ifndef ATTN_DEFER
#define ATTN_DEFER 1
#endif
constexpr int NB = 8, SEQ = 2048, T = NB * SEQ, DM = 1024;
constexpr int NIN = 6144;
constexpr int C_Q = 0, C_KV = 512, C_SGU = 1280, C_MQ = 2304, C_MG = 2816, C_NG = 5888;
constexpr int S_Q = 0, S_NG = 1280, S_SGU = 1304, S_MQ = 2328, S_MG = 2840, IN_W = 5912;
constexpr int NEXP = 32, FF = 256, XS_ROWS = T * 2 + NEXP * 256;
constexpr float LN_EPS = 1e-5f, DN_ALPHA = 1.189207115002721f;
constexpr float LOG2E = 1.4426950408889634f;
constexpr float QSCALE = 0.125f * LOG2E;
constexpr float MQSCALE = 0.08838834764831845f * LOG2E;
constexpr int NWAVES = 8, NTHR = 512;

constexpr size_t MiB = 1u << 20, KiB = 1u << 10;
constexpr size_t WS_CTL = 0, CTL_ZERO_BYTES = 128 * KiB;
constexpr size_t WS_ROPE = 1 * MiB;
constexpr size_t WS_SGUW = 1 * MiB + 512 * KiB;
constexpr size_t WS_KCMP = 2 * MiB, WS_VCMP = 2 * MiB + 256 * KiB;
constexpr size_t WS_W2T = 2 * MiB + 512 * KiB;
constexpr size_t WS_TOK = 3 * MiB;
constexpr size_t WS_WRH = 3 * MiB + 512 * KiB, WS_WRL = 3 * MiB + 640 * KiB;
constexpr size_t WS_NG = 4 * MiB;
constexpr size_t WS_WMEMT = 6 * MiB;
constexpr size_t WS_WBRT = 8 * MiB;
constexpr size_t WS_WOT = 11 * MiB;
constexpr size_t WS_W1T = 13 * MiB;
constexpr size_t WS_TOKOF = 15 * MiB;
constexpr size_t WS_CWT = 15 * MiB + 256 * KiB;
constexpr size_t WS_WINT = 16 * MiB;
constexpr size_t WS_MEMBF = 28 * MiB;
constexpr size_t WS_XBF = 32 * MiB;
constexpr size_t WS_WGUT = 16 * MiB;
constexpr size_t WS_WDT = 48 * MiB;
constexpr size_t WS_Q = 64 * MiB;
constexpr size_t WS_KV = 80 * MiB;
constexpr size_t WS_Z = 104 * MiB;
constexpr size_t WS_Y = 104 * MiB;
constexpr size_t WS_MQ = 136 * MiB;
constexpr size_t WS_MG = 152 * MiB;
constexpr size_t WS_KVMEM = 248 * MiB;
constexpr size_t WS_XS = 64 * MiB;
constexpr size_t WS_H = 144 * MiB;
constexpr size_t WS_X1BF = 104 * MiB;
constexpr size_t WS_FBUF = 192 * MiB;
constexpr size_t WS_XBUF = 15 * MiB + 512 * KiB;
constexpr size_t WS_PLG = 200 * MiB;
constexpr size_t WS_END = 256 * MiB;
constexpr size_t DO_OSGU = 0, DO_ONSA = 16 * MiB, DO_ONF = 32 * MiB;
constexpr int LIST_CAP = T;
constexpr size_t DO_LIST = 32 * MiB, DO_WLIST = 34 * MiB;
static_assert(WS_X1BF + (size_t)T * 2048 <= WS_H && WS_H + (size_t)XS_ROWS * 256 * 2 <= WS_FBUF && WS_FBUF + (size_t)T * 4096 <= WS_END, "ws map");
constexpr int CW_CNT = 256;
constexpr int CW_BAR = 4096;

constexpr int LDS_MISC = 0;
constexpr int LDS_WORK = 1024;
constexpr int LDS_BYTES = 155648;
namespace pg8 {
#define PG8_LAS __attribute__((address_space(3)))
typedef unsigned short bf16_t;
typedef short bf16x8 __attribute__((ext_vector_type(8)));
typedef float f32x4 __attribute__((ext_vector_type(4)));
typedef unsigned u32x4 __attribute__((ext_vector_type(4)));
constexpr int BM = 256, BK = 64, HALF = 128, HTB = HALF * BK * 2  , STAGE_BYTES = 8 * HTB, NXCD = 8, WGM = 8;

__host__ __device__ __forceinline__ int lds_byte(int r, int c) { const int st = (r >> 4) * 2 + (c >> 5), rr = r & 15, cc = c & 31, ob = rr * 64 + cc * 2; return st * 1024 + (ob ^ (((ob >> 9) & 1) << 5)); }
__host__ __device__ __forceinline__ void stage_rc(int b, int& R, int& C) { const int st = b / 1024, sb = b % 1024, swz = sb ^ (((sb >> 9) & 1) << 5); R = (st >> 1) * 16 + swz / 64; C = (st & 1) * 32 + (swz % 64) / 2; }
__host__ __device__ __forceinline__ int perm32(int rho) { const int n = rho >> 4, i = rho & 15; return 8 * (i >> 2) + 4 * n + (i & 3); }

struct Unit { int pm, pn, hm; };
struct Gemm { const bf16_t* A; const bf16_t* Bt; int M, N, K; };

struct StaticOrder {
    int nM, nN, nwg, G, c;
    __host__ __device__ void init(int M, int N, int G_, int c_) { nM = M / BM; nN = N / BM; nwg = nM * nN; G = G_; c = c_; }
    __host__ __device__ __forceinline__ bool next(int i, Unit& u) const {
        const long L = (long)i * G + c; if (L >= nwg) return false;
        int wgid = (int)L; { const int q = nwg / NXCD, r = nwg % NXCD, xcd = wgid % NXCD, off = wgid / NXCD; wgid = (xcd < r ? xcd * (q + 1) : r * (q + 1) + (xcd - r) * q) + off; }
        const int nig = WGM * nN, gid = wgid / nig, fm = gid * WGM, gsz = (nM - fm) < WGM ? (nM - fm) : WGM;
        u.pm = fm + ((wgid % nig) % gsz); u.pn = (wgid % nig) / gsz; return true;
    }
    static constexpr bool GATHER = false, HALFM = false;
    __device__ __forceinline__ unsigned rowoff(const Unit&, int) const { return 0u; }
    __device__ __forceinline__ void a_ready(const Unit&) const {}
    __device__ __forceinline__ void done(const Unit&) const {}
    __device__ __forceinline__ const char* pa(const Gemm& g, const Unit& u, size_t tstep) const { return (const char*)g.A + (size_t)u.pm * tstep; }
    __device__ __forceinline__ const char* pb(const Gemm& g, const Unit& u, size_t tstep) const { return (const char*)g.Bt + (size_t)u.pn * tstep; }
};

typedef float f32x2_t_ __attribute__((ext_vector_type(2))); typedef __bf16 bf16x2_t_ __attribute__((ext_vector_type(2)));
__device__ __forceinline__ unsigned cvt_pk_bf16(float lo, float hi) { f32x2_t_ v = {lo, hi}; bf16x2_t_ b = __builtin_convertvector(v, bf16x2_t_); return __builtin_bit_cast(unsigned, b); }
typedef float f32x2 __attribute__((ext_vector_type(2)));
__device__ __forceinline__ f32x2 gelu_pk(f32x2 v) {
    const f32x2 av = __builtin_elementwise_abs(v), d = av * 0.2316418882f + 1.0f;
    f32x2 t; t.x = __builtin_amdgcn_rcpf(d.x); t.y = __builtin_amdgcn_rcpf(d.y);
    f32x2 q = t * 0.5307027145f + (-0.7265760135f); q = q * t + 0.7107068705f; q = q * t + (-0.142248368f); q = q * t + 0.127414796f; q = q * t;
    const f32x2 s = (v * v) * (-0.72134752044f);
    f32x2 e; e.x = __builtin_amdgcn_exp2f(s.x); e.y = __builtin_amdgcn_exp2f(s.y);
    const f32x2 m = v * (q * e), r = v - m;
    f32x2 o; o.x = v.x < 0.f ? m.x : r.x; o.y = v.y < 0.f ? m.y : r.y; return o;
}

template <class Epi, class Sched, bool ALIGN_EPI = false, bool SP2 = false>
__device__ __forceinline__ void gemm_phase(PG8_LAS unsigned char* lds, const Gemm g, const Sched& S, const Epi& E, int wv) {
    const int tid = opaque_tid(wv), wid = __builtin_amdgcn_readfirstlane(tid >> 6), lane = tid & 63, wr = wid >> 2, wc = wid & 3, fr = lane & 15, fq = lane >> 4;
    const int K = g.K, nt = K / BK;
    unsigned voffA[2], voffB[2];
#pragma unroll
    for (int i = 0; i < 2; ++i) { int R, C; stage_rc(tid * 16 + i * 8192, R, C); const int Rb = Epi::PERM ? ((R & ~31) + perm32(R & 31)) : R;
        voffA[i] = (unsigned)(R * K + C) * 2u; voffB[i] = (unsigned)(Rb * K + C) * 2u; }
    const size_t kstep = (size_t)(BK * 2);
    const size_t hstep = (size_t)HALF * K * 2;
    const size_t tstep = 2 * hstep;
    const unsigned ldsw = (unsigned)wid * 1024u;
    const int aoff = lds_byte(wr * 64 + fr, fq * 8), boff = lds_byte(wc * 32 + fr, fq * 8);
#define PG8_SA(b, h) (((b) * 2 + (h)) * HTB)
#define PG8_SB(b, h) ((4 + (b) * 2 + (h)) * HTB)
#define PG8_STAGE(bufoff, gbase, voff) do { _Pragma("unroll") for (int _i = 0; _i < 2; ++_i) \
        __builtin_amdgcn_global_load_lds((const unsigned*)((const char*)(gbase) + (voff)[_i]), (PG8_LAS unsigned*)(lds + (bufoff) + ldsw + _i * 8192), 16, 0, 0); } while (0)
#define PG8_STAGE_A(bufoff, abase, h, VG) do { if constexpr (Sched::GATHER) { _Pragma("unroll") for (int _i = 0; _i < 2; ++_i) \
        __builtin_amdgcn_global_load_lds((const unsigned*)((const char*)(abase) + (VG)[h][_i]), (PG8_LAS unsigned*)(lds + (bufoff) + ldsw + _i * 8192), 16, 0, 0); } \
    else { PG8_STAGE(bufoff, (const char*)(abase) + (h) * hstep, voffA); } } while (0)
#define PG8_LDA(dst, b, h) do { _Pragma("unroll") for (int m = 0; m < 4; ++m) _Pragma("unroll") for (int k = 0; k < 2; ++k) dst[m][k] = *(const PG8_LAS bf16x8*)(lds + PG8_SA(b, h) + aoff + m * 2048 + k * 1024); } while (0)
#define PG8_LDB(dst, b, h) do { _Pragma("unroll") for (int n = 0; n < 2; ++n) _Pragma("unroll") for (int k = 0; k < 2; ++k) dst[n][k] = *(const PG8_LAS bf16x8*)(lds + PG8_SB(b, h) + boff + n * 2048 + k * 1024); } while (0)
#define PG8_MMA(ai, bj, At, Bt) do { __builtin_amdgcn_s_setprio(1); _Pragma("unroll") for (int m = 0; m < 4; ++m) _Pragma("unroll") for (int n = 0; n < 2; ++n) _Pragma("unroll") for (int k = 0; k < 2; ++k) \
        acc[ai][bj][m][n] = __builtin_amdgcn_mfma_f32_16x16x32_bf16(Bt[n][k], At[m][k], acc[ai][bj][m][n], 0, 0, 0); __builtin_amdgcn_s_setprio(0); } while (0)
#define PG8_WAIT_V(n) asm volatile("s_waitcnt vmcnt(" #n ")" ::: "memory")
#define PG8_WAIT_L(n) asm volatile("s_waitcnt lgkmcnt(" #n ")" ::: "memory")
#define PG8_BAR __builtin_amdgcn_s_barrier()
#define PG8_SCHED __builtin_amdgcn_sched_barrier(0)
    Unit cur, nxt; int ui = 0;
    if (!S.next(0, cur)) return;
    f32x4 acc[2][2][4][2];
#pragma unroll
    for (int a = 0; a < 2; ++a)
#pragma unroll
        for (int b = 0; b < 2; ++b)
#pragma unroll
            for (int m = 0; m < 4; ++m)
#pragma unroll
                for (int n = 0; n < 2; ++n) acc[a][b][m][n] = (f32x4){0.f, 0.f, 0.f, 0.f};
    bf16x8 At[4][2], B0[2][2], B1[2][2];
    const char* cA = S.pa(g, cur, tstep); const char* cB = S.pb(g, cur, tstep);
    S.a_ready(cur);
    unsigned VC[2][2] = {{0u, 0u}, {0u, 0u}}, VN[2][2] = {{0u, 0u}, {0u, 0u}};
    int gR[2], gC[2];
#pragma unroll
    for (int i = 0; i < 2; ++i) stage_rc(tid * 16 + i * 8192, gR[i], gC[i]);
    static_assert(!Sched::HALFM || (Sched::GATHER && SP2), "half units: gathered A rows, SP2 schedule");
#define PG8_RB(u, h) ((Sched::HALFM && (u).hm != 0) ? ((u).hm - 1) * HALF : (h) * HALF)
    if constexpr (Sched::GATHER) {
#pragma unroll
        for (int h = 0; h < 2; ++h)
#pragma unroll
            for (int i = 0; i < 2; ++i) VC[h][i] = S.rowoff(cur, PG8_RB(cur, h) + gR[i]) + (unsigned)gC[i] * 2u; }
    if constexpr (SP2) {
        PG8_STAGE(PG8_SB(0, 0), cB, voffB); PG8_STAGE(PG8_SB(0, 1), cB + hstep, voffB); PG8_STAGE_A(PG8_SA(0, 0), cA, 0, VC); PG8_STAGE_A(PG8_SA(0, 1), cA, 1, VC);
        if (wr == 1) PG8_BAR;
        PG8_WAIT_V(2); PG8_BAR;
        PG8_STAGE(PG8_SB(1, 0), cB + kstep, voffB); PG8_STAGE_A(PG8_SA(1, 0), cA + kstep, 0, VC); PG8_STAGE(PG8_SB(1, 1), cB + hstep + kstep, voffB);
        PG8_WAIT_V(6); PG8_BAR;
    } else {
        PG8_STAGE(PG8_SB(0, 0), cB, voffB); PG8_STAGE_A(PG8_SA(0, 0), cA, 0, VC); PG8_STAGE(PG8_SB(0, 1), cB + hstep, voffB); PG8_STAGE_A(PG8_SA(0, 1), cA, 1, VC);
        if (wr == 1) PG8_BAR;
        PG8_WAIT_V(4); PG8_BAR;
        PG8_STAGE(PG8_SB(1, 0), cB + kstep, voffB); PG8_STAGE_A(PG8_SA(1, 0), cA + kstep, 0, VC); PG8_STAGE(PG8_SB(1, 1), cB + hstep + kstep, voffB);
        PG8_WAIT_V(6); PG8_BAR;
    }
    for (;;) {
        const bool has_next = S.next(ui + 1, nxt);
        const char* nA = has_next ? S.pa(g, nxt, tstep) : cA; const char* nB = has_next ? S.pb(g, nxt, tstep) : cB;
        if constexpr (Sched::GATHER) {
#pragma unroll
            for (int h = 0; h < 2; ++h)
#pragma unroll
                for (int i = 0; i < 2; ++i) VN[h][i] = has_next ? S.rowoff(nxt, PG8_RB(nxt, h) + gR[i]) + (unsigned)gC[i] * 2u : VC[h][i]; }
        bool hf = false; if constexpr (Sched::HALFM) hf = cur.hm != 0;
        for (int t = 0; t < nt; t += 2) {
            const bool last = (t == nt - 2);
            const char* a1 = cA + (size_t)(t + 1) * kstep;
            const char* a2 = last ? nA : cA + (size_t)(t + 2) * kstep; const char* b2 = last ? nB : cB + (size_t)(t + 2) * kstep;
            const char* a3 = a2 + kstep; const char* b3 = b2 + kstep;
            if (last && has_next) S.a_ready(nxt);
            unsigned V2[2][2];
#pragma unroll
            for (int h = 0; h < 2; ++h)
#pragma unroll
                for (int i = 0; i < 2; ++i) V2[h][i] = last ? VN[h][i] : VC[h][i];
            if constexpr (SP2) {
            PG8_LDB(B0, 0, 0); PG8_LDB(B1, 0, 1); PG8_SCHED; PG8_LDA(At, 0, 0); PG8_STAGE_A(PG8_SA(1, 1), a1, 1, VC);
            PG8_WAIT_V(8); PG8_WAIT_L(0); PG8_BAR; PG8_MMA(0, 0, At, B0); PG8_MMA(0, 1, At, B1); PG8_BAR; PG8_SCHED;
            if constexpr (Sched::HALFM) { if (!hf) PG8_LDA(At, 0, 1); } else PG8_LDA(At, 0, 1);
            PG8_STAGE(PG8_SB(0, 0), b2, voffB); PG8_STAGE(PG8_SB(0, 1), b2 + hstep, voffB); PG8_STAGE_A(PG8_SA(0, 0), a2, 0, V2);
            PG8_WAIT_V(8); PG8_WAIT_L(0); PG8_BAR;
            if constexpr (Sched::HALFM) { if (!hf) { PG8_MMA(1, 0, At, B0); PG8_MMA(1, 1, At, B1); } } else { PG8_MMA(1, 0, At, B0); PG8_MMA(1, 1, At, B1); }
            PG8_BAR; PG8_SCHED;
            PG8_LDB(B0, 1, 0); PG8_LDB(B1, 1, 1); PG8_SCHED; PG8_LDA(At, 1, 0); PG8_STAGE_A(PG8_SA(0, 1), a2, 1, V2);
            PG8_WAIT_V(8); PG8_WAIT_L(0); PG8_BAR; PG8_MMA(0, 0, At, B0); PG8_MMA(0, 1, At, B1); PG8_BAR; PG8_SCHED;
            if constexpr (Sched::HALFM) { if (!hf) PG8_LDA(At, 1, 1); } else PG8_LDA(At, 1, 1);
            PG8_STAGE(PG8_SB(1, 0), b3, voffB); PG8_STAGE(PG8_SB(1, 1), b3 + hstep, voffB); PG8_STAGE_A(PG8_SA(1, 0), a3, 0, V2);
            PG8_WAIT_V(8); PG8_WAIT_L(0); PG8_BAR;
            if constexpr (Sched::HALFM) { if (!hf) { PG8_MMA(1, 0, At, B0); PG8_MMA(1, 1, At, B1); } } else { PG8_MMA(1, 0, At, B0); PG8_MMA(1, 1, At, B1); }
            PG8_BAR; PG8_SCHED;
            } else {
            PG8_LDB(B0, 0, 0); PG8_SCHED; PG8_LDA(At, 0, 0); PG8_STAGE_A(PG8_SA(1, 1), a1, 1, VC);
            PG8_WAIT_L(8); PG8_BAR; PG8_WAIT_L(0); PG8_MMA(0, 0, At, B0); PG8_BAR; PG8_SCHED;
            PG8_LDB(B1, 0, 1); PG8_STAGE(PG8_SB(0, 0), b2, voffB);
            PG8_BAR; PG8_WAIT_L(0); PG8_MMA(0, 1, At, B1); PG8_BAR;
            PG8_LDA(At, 0, 1); PG8_STAGE_A(PG8_SA(0, 0), a2, 0, V2);
            PG8_BAR; PG8_WAIT_L(0); PG8_MMA(1, 0, At, B0); PG8_BAR; PG8_SCHED;
            PG8_STAGE(PG8_SB(0, 1), b2 + hstep, voffB);
            PG8_WAIT_V(6); PG8_BAR; PG8_MMA(1, 1, At, B1); PG8_BAR;
            PG8_LDB(B0, 1, 0); PG8_SCHED; PG8_LDA(At, 1, 0); PG8_STAGE_A(PG8_SA(0, 1), a2, 1, V2);
            PG8_WAIT_L(8); PG8_BAR; PG8_WAIT_L(0); PG8_MMA(0, 0, At, B0); PG8_BAR; PG8_SCHED;
            PG8_LDB(B1, 1, 1); PG8_STAGE(PG8_SB(1, 0), b3, voffB);
            PG8_BAR; PG8_WAIT_L(0); PG8_MMA(0, 1, At, B1); PG8_BAR;
            PG8_LDA(At, 1, 1); PG8_STAGE_A(PG8_SA(1, 0), a3, 0, V2);
            PG8_BAR; PG8_WAIT_L(0); PG8_MMA(1, 0, At, B0); PG8_BAR; PG8_SCHED;
            PG8_STAGE(PG8_SB(1, 1), b3 + hstep, voffB);
            PG8_WAIT_V(6); PG8_BAR; PG8_MMA(1, 1, At, B1); PG8_BAR;
            }
        }
        if constexpr (ALIGN_EPI) { if (wr == 0) PG8_BAR; }
        if constexpr (!Epi::AFTER_DRAIN) { int l2_; asm volatile("v_mbcnt_lo_u32_b32 %0, -1, 0\n\tv_mbcnt_hi_u32_b32 %0, -1, %0" : "=v"(l2_));        const int fr2 = l2_ & 15, fq2 = l2_ >> 4;
            E(acc, cur, wr, wc, fr2, fq2); S.done(cur); }
        if (!has_next) break;
        if (!E.keep(cur)) {
#pragma unroll
        for (int a = 0; a < 2; ++a)
#pragma unroll
            for (int b = 0; b < 2; ++b)
#pragma unroll
                for (int m = 0; m < 4; ++m)
#pragma unroll
                    for (int n = 0; n < 2; ++n) acc[a][b][m][n] = (f32x4){0.f, 0.f, 0.f, 0.f};
        }
        cur = nxt; cA = nA; cB = nB; ++ui;
        if constexpr (Sched::GATHER) {
#pragma unroll
            for (int h = 0; h < 2; ++h)
#pragma unroll
                for (int i = 0; i < 2; ++i) VC[h][i] = VN[h][i]; }
        if constexpr (ALIGN_EPI) { if (wr == 1) PG8_BAR; }
    }
    PG8_WAIT_V(0);
    if constexpr (!ALIGN_EPI) { if (wr == 0) PG8_BAR; }
    PG8_BAR;
    if constexpr (Epi::AFTER_DRAIN) { E.fused(acc, cur, wr, wc, fr, fq, lds, wid, lane); S.done(cur); }
#undef PG8_SA
#undef PG8_RB
#undef PG8_SB
#undef PG8_STAGE
#undef PG8_STAGE_A
#undef PG8_LDA
#undef PG8_LDB
#undef PG8_MMA
#undef PG8_WAIT_V
#undef PG8_WAIT_L
#undef PG8_BAR
#undef PG8_SCHED
}
}
#define GAS __attribute__((address_space(1)))
#define LAS __attribute__((address_space(3)))
typedef unsigned short bf16;
typedef unsigned u32x4 __attribute__((ext_vector_type(4)));
typedef unsigned u32x2 __attribute__((ext_vector_type(2)));
typedef float f32x4 __attribute__((ext_vector_type(4)));
typedef float f32x2 __attribute__((ext_vector_type(2)));
typedef short bf16x8 __attribute__((ext_vector_type(8)));
typedef short s16x4 __attribute__((ext_vector_type(4)));
typedef GAS unsigned gu32;
#define RLX_AGENT __ATOMIC_RELAXED, __HIP_MEMORY_SCOPE_AGENT
#define LDS_WAIT() asm volatile("s_waitcnt lgkmcnt(0)" ::: "memory")
#define VM_WAIT() asm volatile("s_waitcnt vmcnt(0)" ::: "memory")
__device__ __forceinline__ unsigned f2bf(float f) { unsigned u = __builtin_bit_cast(unsigned, f); return (u + 0x7fffu + ((u >> 16) & 1u)) >> 16; }
__device__ __forceinline__ unsigned pk2(float lo, float hi) { return f2bf(lo) | (f2bf(hi) << 16); }
__device__ __forceinline__ float bf2f(unsigned h) { return __builtin_bit_cast(float, h << 16); }
__device__ __forceinline__ float bflo(unsigned w) { return __builtin_bit_cast(float, w << 16); }
__device__ __forceinline__ float bfhi(unsigned w) { return __builtin_bit_cast(float, w & 0xffff0000u); }
__device__ __forceinline__ float fast_exp2(float x) { return __builtin_amdgcn_exp2f(x); }
__device__ __forceinline__ float sigmoidf_(float x) { return __builtin_amdgcn_rcpf(1.0f + fast_exp2(-x * LOG2E)); }
template <int CTRL> __device__ __forceinline__ float dpp(float x) { return __builtin_bit_cast(float, __builtin_amdgcn_mov_dpp(__builtin_bit_cast(int, x), CTRL, 0xf, 0xf, true)); }
__device__ __forceinline__ void swap16(unsigned& a, unsigned& b) { asm volatile("s_nop 1\n\tv_permlane16_swap_b32 %0, %1" : "+v"(a), "+v"(b)); }
__device__ __forceinline__ void swap32(unsigned& a, unsigned& b) { asm volatile("s_nop 1\n\tv_permlane32_swap_b32 %0, %1" : "+v"(a), "+v"(b)); }
__device__ __forceinline__ float xrow16_max(float x) {
    unsigned a = __builtin_bit_cast(unsigned, x), b = a; swap16(a, b); x = fmaxf(__builtin_bit_cast(float, a), __builtin_bit_cast(float, b));
    a = __builtin_bit_cast(unsigned, x); b = a; swap32(a, b); return fmaxf(__builtin_bit_cast(float, a), __builtin_bit_cast(float, b));
}
__device__ __forceinline__ float xrow16_sum(float x) {
    unsigned a = __builtin_bit_cast(unsigned, x), b = a; swap16(a, b); x = __builtin_bit_cast(float, a) + __builtin_bit_cast(float, b);
    a = __builtin_bit_cast(unsigned, x); b = a; swap32(a, b); return __builtin_bit_cast(float, a) + __builtin_bit_cast(float, b);
}
__device__ __forceinline__ unsigned xrow16_or(unsigned x) { unsigned a = x, b = x; swap16(a, b); x = a | b; a = x; b = x; swap32(a, b); return a | b; }
__device__ __forceinline__ unsigned xrow16_umax(unsigned x) { unsigned a = x, b = x; swap16(a, b); x = a > b ? a : b; a = x; b = x; swap32(a, b); return a > b ? a : b; }
__device__ __forceinline__ float wave_sum(float v) {
#if WSUM_DPP
    v += dpp<0xB1>(v); v += dpp<0x4E>(v); v += dpp<0x124>(v); v += dpp<0x128>(v);
    return __builtin_bit_cast(float, __builtin_amdgcn_readfirstlane(__builtin_bit_cast(int, xrow16_sum(v))));
#else
#pragma unroll
    for (int o = 1; o < 64; o <<= 1) v += __shfl_xor(v, o);
    return v;
#endif
}

__device__ __forceinline__ size_t mg_index(int pm, int j, int ai, int m, int bj, int wr, int wc, int fr, int fq) {
    return ((((size_t)(pm * 12 + j) * 2 + ai) * 4 + m) * 2 + bj) * 512 + (wr * 4 + wc) * 64 + fq * 16 + fr; }
struct EpiInProj {
    static constexpr bool PERM = true, AFTER_DRAIN = false;
    __device__ __forceinline__ bool keep(const pg8::Unit&) const { return false; }
    bf16 *Q, *KV, *Z, *MQ, *MG, *KVM; const float* rope;
    template <int KIND, int LDC>
    __device__ __forceinline__ void run(const f32x4 (&acc)[2][2][4][2], const pg8::Unit& u, bf16* base, int colt, int wr, int wc, int fr, int fq) const {
        const int pn = u.pn; const int row0 = u.pm * 256 + wr * 64 + fr; const int c0 = wc * 32 + 8 * fq;
        const bool ropew = (KIND <= 1) && ((wc & 1) == 0);
#pragma unroll
        for (int ai = 0; ai < 2; ++ai) {
            f32x4 tbl[4][4];
            if (ropew) {
#pragma unroll
                for (int m = 0; m < 4; ++m) { const f32x4* cs = (const f32x4*)(rope + (size_t)((row0 + ai * 128 + m * 16) & (SEQ - 1)) * 16);
#pragma unroll
                    for (int q = 0; q < 4; ++q) tbl[m][q] = cs[q]; }
                __builtin_amdgcn_sched_barrier(0); }
#pragma unroll
            for (int m = 0; m < 4; ++m) {
                const int r = row0 + ai * 128 + m * 16;
#pragma unroll
                for (int bj = 0; bj < 2; ++bj) {
                    f32x4 v0 = acc[ai][bj][m][0], v1 = acc[ai][bj][m][1];
                    if (KIND <= 1) {
                        if (ropew && (KIND == 0 || bj == 0)) {
                            f32x4 p0, p1;
#pragma unroll
                            for (int i = 0; i < 4; ++i) { p0[i] = __shfl_xor(v0[i], 16); p1[i] = __shfl_xor(v1[i], 16); }
                            if (fq < 2) {
                                const f32x4 t0 = tbl[m][0], t1 = tbl[m][1], t2 = tbl[m][2], t3 = tbl[m][3];
                                const float sg = fq == 0 ? -1.f : 1.f;
                                v0[0] = v0[0] * t0[0] + sg * p0[0] * t0[1]; v0[1] = v0[1] * t0[2] + sg * p0[1] * t0[3];
                                v0[2] = v0[2] * t1[0] + sg * p0[2] * t1[1]; v0[3] = v0[3] * t1[2] + sg * p0[3] * t1[3];
                                v1[0] = v1[0] * t2[0] + sg * p1[0] * t2[1]; v1[1] = v1[1] * t2[2] + sg * p1[1] * t2[3];
                                v1[2] = v1[2] * t3[0] + sg * p1[2] * t3[1]; v1[3] = v1[3] * t3[2] + sg * p1[3] * t3[3];
                            }
                        }
                        if (KIND == 0) { v0 = v0 * QSCALE; v1 = v1 * QSCALE; }
                    } else if (KIND == 2) {
                        pg8::f32x2 a = pg8::gelu_pk((pg8::f32x2){v0[0], v0[1]}), b = pg8::gelu_pk((pg8::f32x2){v0[2], v0[3]}), c = pg8::gelu_pk((pg8::f32x2){v1[0], v1[1]}), d = pg8::gelu_pk((pg8::f32x2){v1[2], v1[3]});
                        v0 = (f32x4){a.x, a.y, b.x, b.y}; v1 = (f32x4){c.x, c.y, d.x, d.y};
                    } else if (KIND == 3) { v0 = v0 * MQSCALE; v1 = v1 * MQSCALE; }
                    else if (KIND == 4) {
#pragma unroll
                        for (int i = 0; i < 4; i += 2) {
                            pg8::f32x2 ta = (pg8::f32x2){v0[i], v0[i + 1]} * (-LOG2E), tb = (pg8::f32x2){v1[i], v1[i + 1]} * (-LOG2E);
                            pg8::f32x2 ea, eb; ea.x = fast_exp2(ta.x); ea.y = fast_exp2(ta.y); eb.x = fast_exp2(tb.x); eb.y = fast_exp2(tb.y);
                            const pg8::f32x2 da = ea * (1.0f / 255.0f) + (1.0f / 255.0f), db = eb * (1.0f / 255.0f) + (1.0f / 255.0f);
                            v0[i] = __builtin_amdgcn_rcpf(da.x); v0[i + 1] = __builtin_amdgcn_rcpf(da.y); v1[i] = __builtin_amdgcn_rcpf(db.x); v1[i + 1] = __builtin_amdgcn_rcpf(db.y); }
                    }
                    { u32x4 w; w.x = pg8::cvt_pk_bf16(v0[0], v0[1]); w.y = pg8::cvt_pk_bf16(v0[2], v0[3]); w.z = pg8::cvt_pk_bf16(v1[0], v1[1]); w.w = pg8::cvt_pk_bf16(v1[2], v1[3]);
                      if (KIND == 4) { u32x2 q8;
                          q8.x = __builtin_amdgcn_cvt_pk_u8_f32(v0[3], 3, __builtin_amdgcn_cvt_pk_u8_f32(v0[2], 2, __builtin_amdgcn_cvt_pk_u8_f32(v0[1], 1, __builtin_amdgcn_cvt_pk_u8_f32(v0[0], 0, 0u))));
                          q8.y = __builtin_amdgcn_cvt_pk_u8_f32(v1[3], 3, __builtin_amdgcn_cvt_pk_u8_f32(v1[2], 2, __builtin_amdgcn_cvt_pk_u8_f32(v1[1], 1, __builtin_amdgcn_cvt_pk_u8_f32(v1[0], 0, 0u))));
                          ((u32x2*)MG)[mg_index(u.pm, pn - 11, ai, m, bj, wr, wc, fr, fq)] = q8; }
                      else *(u32x4*)(base + (size_t)r * LDC + colt + bj * 128 + c0) = w; }
                }
            }
        }
    }
    __device__ __forceinline__ void operator()(const f32x4 (&acc)[2][2][4][2], const pg8::Unit& u, int wr, int wc, int fr, int fq) const {
        const int pn = u.pn;
        if (pn >= 100) run<5, 1024>(acc, u, KVM, (pn - 100) * 256, wr, wc, fr, fq);
        else if (pn < 2) run<0, 512>(acc, u, Q, pn * 256, wr, wc, fr, fq);
        else if (pn < 5) run<1, 768>(acc, u, KV, (pn - 2) * 256, wr, wc, fr, fq);
        else if (pn < 9) run<2, 1024>(acc, u, Z, (pn - 5) * 256, wr, wc, fr, fq);
        else if (pn < 11) run<3, 512>(acc, u, MQ, (pn - 9) * 256, wr, wc, fr, fq);
        else run<4, 3072>(acc, u, MG, (pn - 11) * 256, wr, wc, fr, fq);
    }
};
struct EpiBf16Plain {
    static constexpr bool PERM = true, AFTER_DRAIN = false;
    __device__ __forceinline__ bool keep(const pg8::Unit&) const { return false; }
    bf16* O; int ldc;
    __device__ __forceinline__ void operator()(const f32x4 (&acc)[2][2][4][2], const pg8::Unit& u, int wr, int wc, int fr, int fq) const {
        const int row0 = u.pm * 256 + wr * 64 + fr, col0 = u.pn * 256 + wc * 32 + 8 * fq;
#pragma unroll
        for (int ai = 0; ai < 2; ++ai)
#pragma unroll
            for (int m = 0; m < 4; ++m)
#pragma unroll
                for (int bj = 0; bj < 2; ++bj) { const f32x4 v0 = acc[ai][bj][m][0], v1 = acc[ai][bj][m][1];
                    u32x4 w; w.x = pg8::cvt_pk_bf16(v0[0], v0[1]); w.y = pg8::cvt_pk_bf16(v0[2], v0[3]); w.z = pg8::cvt_pk_bf16(v1[0], v1[1]); w.w = pg8::cvt_pk_bf16(v1[2], v1[3]);
                    *(u32x4*)(O + (size_t)(row0 + ai * 128 + m * 16) * ldc + col0 + bj * 128) = w; }
    }
};
struct EpiBranch {
    static constexpr bool PERM = true, AFTER_DRAIN = false;
    bf16* Y; const bf16* MG;
    __device__ __forceinline__ bool keep(const pg8::Unit& u) const { return u.pn < 8; }
    __device__ __forceinline__ void operator()(f32x4 (&acc)[2][2][4][2], const pg8::Unit& u, int wr, int wc, int fr, int fq) const {
        const int row0 = u.pm * 256 + wr * 64 + fr, cin = wc * 32 + 8 * fq; const bool last = u.pn >= 8;
        u32x2 gq[2][4][2], hq[2][4][2];
#pragma unroll
        for (int ai = 0; ai < 2; ++ai)
#pragma unroll
            for (int m = 0; m < 4; ++m)
#pragma unroll
                for (int bj = 0; bj < 2; ++bj) { const u32x2* gp = (const u32x2*)MG + mg_index(u.pm, u.pn, ai, m, bj, wr, wc, fr, fq);
                    gq[ai][m][bj] = *gp; hq[ai][m][bj] = last ? (u32x2){0xFFFFFFFFu, 0xFFFFFFFFu} : gp[(size_t)4 * 2 * 4 * 2 * 512]; }
        __builtin_amdgcn_sched_barrier(0);
#pragma unroll
        for (int ai = 0; ai < 2; ++ai)
#pragma unroll
            for (int m = 0; m < 4; ++m)
#pragma unroll
                for (int bj = 0; bj < 2; ++bj) {
                    const u32x2 g = gq[ai][m][bj], h = hq[ai][m][bj]; constexpr float TQ = 1e-30f * 255.0f;
                    const float gc[8] = {(float)(g.x & 255u), (float)((g.x >> 8) & 255u), (float)((g.x >> 16) & 255u), (float)(g.x >> 24), (float)(g.y & 255u), (float)((g.y >> 8) & 255u), (float)((g.y >> 16) & 255u), (float)(g.y >> 24)};
                    const float nx[8] = {(float)(h.x & 255u), (float)((h.x >> 8) & 255u), (float)((h.x >> 16) & 255u), (float)(h.x >> 24), (float)(h.y & 255u), (float)((h.y >> 8) & 255u), (float)((h.y >> 16) & 255u), (float)(h.y >> 24)};
                    float sc[8];
#pragma unroll
                    for (int i = 0; i < 8; ++i) sc[i] = fmaxf(gc[i], TQ) * __builtin_amdgcn_rcpf(fmaxf(nx[i], TQ));
                    f32x4& v0 = acc[ai][bj][m][0]; f32x4& v1 = acc[ai][bj][m][1];
                    v0[0] *= sc[0]; v0[1] *= sc[1]; v0[2] *= sc[2]; v0[3] *= sc[3]; v1[0] *= sc[4]; v1[1] *= sc[5]; v1[2] *= sc[6]; v1[3] *= sc[7];
                }
        if (last) {
#pragma unroll
            for (int ai = 0; ai < 2; ++ai)
#pragma unroll
                for (int m = 0; m < 4; ++m)
#pragma unroll
                    for (int bj = 0; bj < 2; ++bj) { const size_t r = (size_t)(row0 + ai * 128 + m * 16); const int c = cin + bj * 128; const f32x4 v0 = acc[ai][bj][m][0], v1 = acc[ai][bj][m][1];
                        u32x4 w; w.x = pg8::cvt_pk_bf16(v0[0], v0[1]); w.y = pg8::cvt_pk_bf16(v0[2], v0[3]); w.z = pg8::cvt_pk_bf16(v1[0], v1[1]); w.w = pg8::cvt_pk_bf16(v1[2], v1[3]);
                        bf16* yp = Y + r * 1024 + (u.pn & 3) * 256 + c;
                        asm volatile("global_store_dwordx4 %0, %1, off sc1\n\ts_nop 1" :: "v"(yp), "v"(w) : "memory"); }
        }
    }
};
struct P4Order {
    pg8::StaticOrder so; const unsigned char* outb; const unsigned char* mq;
    unsigned* ycnt;
    __device__ __forceinline__ bool next(int i, pg8::Unit& u) const { const int pass = i % 3; if (!so.next(i / 3, u)) return false; u.pn += 4 * pass; return true; }
    static constexpr bool GATHER = false, HALFM = false;
    __device__ __forceinline__ unsigned rowoff(const pg8::Unit&, int) const { return 0u; }
    __device__ __forceinline__ void a_ready(const pg8::Unit&) const {}
    __device__ __forceinline__ void done(const pg8::Unit& u) const { if (u.pn >= 8) { asm volatile("s_waitcnt vmcnt(0)" ::: "memory");
            if (lane_id() == 0) __hip_atomic_fetch_add(ycnt + 64 * u.pm, 1u, RLX_AGENT); } }
    __device__ __forceinline__ const char* pa(const pg8::Gemm&, const pg8::Unit& u, size_t tstep) const { const size_t off = u.pn < 4 ? DO_ONSA : DO_OSGU;
        const unsigned char* b = u.pn < 8 ? outb + off : mq; return (const char*)b + (size_t)u.pm * tstep; }
    __device__ __forceinline__ const char* pb(const pg8::Gemm& g, const pg8::Unit& u, size_t tstep) const { return (const char*)g.Bt + (size_t)u.pn * tstep; }
};
struct EpiResid {
    static constexpr bool PERM = true, AFTER_DRAIN = false;
    __device__ __forceinline__ bool keep(const pg8::Unit&) const { return false; }
    const float* x; float* out;
    __device__ __forceinline__ void operator()(const f32x4 (&acc)[2][2][4][2], const pg8::Unit& u, int wr, int wc, int fr, int fq) const {
        const int row0 = u.pm * 256 + wr * 64 + fr, col0 = u.pn * 256 + wc * 32 + 8 * fq;
#pragma unroll
        for (int ai = 0; ai < 2; ++ai)
#pragma unroll
            for (int m = 0; m < 4; ++m)
#pragma unroll
                for (int bj = 0; bj < 2; ++bj) {
                    const size_t o = (size_t)(row0 + ai * 128 + m * 16) * 1024 + col0 + bj * 128;
                    const f32x4 x0 = __builtin_nontemporal_load((const f32x4*)(x + o)), x1 = __builtin_nontemporal_load((const f32x4*)(x + o + 4));
                    *(f32x4*)(out + o) = x0 * DN_ALPHA + acc[ai][bj][m][0]; *(f32x4*)(out + o + 4) = x1 * DN_ALPHA + acc[ai][bj][m][1];
                }
    }
};
__device__ __forceinline__ void wave_signal(unsigned* cnt) { asm volatile("s_waitcnt vmcnt(0)" ::: "memory"); if (lane_id() == 0) __hip_atomic_fetch_add(cnt, 1u, RLX_AGENT); }
__device__ __forceinline__ void store_row64_wt(bf16* row64, unsigned (&lo)[4], unsigned (&hi)[4], int q4) {
    swap16(lo[0], lo[1]); swap16(hi[0], hi[1]); swap16(lo[2], lo[3]); swap16(hi[2], hi[3]);
    swap32(lo[0], lo[2]); swap32(hi[0], hi[2]); swap32(lo[1], lo[3]); swap32(hi[1], hi[3]);
    bf16* op = row64 + 16 * q4; const u32x4 w0 = {lo[0], hi[0], lo[1], hi[1]}, w1 = {lo[2], hi[2], lo[3], hi[3]};
    asm volatile("global_store_dwordx4 %0, %1, off sc1\n\tglobal_store_dwordx4 %0, %2, off offset:16 sc1\n\ts_nop 1" :: "v"(op), "v"(w0), "v"(w1) : "memory");
}
constexpr int CW_PAN = 20480;
constexpr int CW_P4 = 30720;
constexpr int CW_Y = 25600, CW_PLG = 29696;
typedef float f32x2v __attribute__((ext_vector_type(2)));
struct PanelStats {
    unsigned long long* xbuf;
    unsigned* cnt; unsigned* tmo; float eps;
    __device__ __forceinline__ void run(const f32x4 (&v)[2][2][4][2], const pg8::Unit& u, int wr, int wc, int fr, int fq, LAS unsigned char* lds, int wid, int lane) const {
        LAS f32x2v* P = (LAS f32x2v*)lds;
        LAS f32x2v* S = (LAS f32x2v*)(lds + 8192);
#pragma unroll
        for (int ai = 0; ai < 2; ++ai)
#pragma unroll
            for (int m = 0; m < 4; ++m) {
                float s = 0.f;
#pragma unroll
                for (int bj = 0; bj < 2; ++bj)
#pragma unroll
                    for (int n = 0; n < 2; ++n) { const f32x4 x = v[ai][bj][m][n]; s += (x[0] + x[1]) + (x[2] + x[3]); }
                s += __shfl_xor(s, 16); s += __shfl_xor(s, 32);
                const float mw = s * (1.0f / 64.0f); float q = 0.f;
#pragma unroll
                for (int bj = 0; bj < 2; ++bj)
#pragma unroll
                    for (int n = 0; n < 2; ++n) { const f32x4 d = v[ai][bj][m][n] - mw; q += (d[0] * d[0] + d[1] * d[1]) + (d[2] * d[2] + d[3] * d[3]); }
                q += __shfl_xor(q, 16); q += __shfl_xor(q, 32);
                if (fq == 0) P[(ai * 128 + wr * 64 + m * 16 + fr) * 4 + wc] = (f32x2v){mw, q};
            }
        asm volatile("s_waitcnt lgkmcnt(0)" ::: "memory"); __builtin_amdgcn_s_barrier(); asm volatile("" ::: "memory");
        const int row = wid * 32 + (lane & 31);
        if (lane < 32) {
            const f32x2v a = P[row * 4 + 0], b = P[row * 4 + 1], c = P[row * 4 + 2], d = P[row * 4 + 3];
            const float mt = (a.x + b.x + c.x + d.x) * 0.25f;
            const float da = a.x - mt, db = b.x - mt, dc = c.x - mt, dd = d.x - mt;
            const float m2 = (a.y + b.y) + (c.y + d.y) + 64.0f * ((da * da + db * db) + (dc * dc + dd * dd));
            __hip_atomic_store(xbuf + ((size_t)(u.pm * 256 + row) * 4 + u.pn), ((unsigned long long)__builtin_bit_cast(unsigned, m2) << 32) | __builtin_bit_cast(unsigned, mt), RLX_AGENT);
        }
        asm volatile("s_waitcnt vmcnt(0)" ::: "memory");
        if (lane == 0) __hip_atomic_fetch_add(cnt + 64 * u.pm, 1u, RLX_AGENT);
        if (wid == 0) { unsigned polls = 0;
            while ((unsigned)__builtin_amdgcn_readfirstlane(__hip_atomic_load(cnt + 64 * u.pm, RLX_AGENT)) < 32u) {
                if (++polls > (1u << 22)) { if (lane == 0) __hip_atomic_store(tmo, 1u, RLX_AGENT); break; }
                __builtin_amdgcn_s_sleep(2); }
            __builtin_amdgcn_fence(__ATOMIC_ACQUIRE, "agent"); }
        asm volatile("s_waitcnt vmcnt(0) lgkmcnt(0)" ::: "memory"); __builtin_amdgcn_s_barrier(); asm volatile("" ::: "memory");
        if (lane < 32) {
            const unsigned long long* slot = xbuf + (size_t)(u.pm * 256 + row) * 4; float mt[4], m2[4]; float ms = 0.f;
#pragma unroll
            for (int t = 0; t < 4; ++t) { const unsigned long long w = __hip_atomic_load(slot + t, RLX_AGENT); mt[t] = __builtin_bit_cast(float, (unsigned)w); m2[t] = __builtin_bit_cast(float, (unsigned)(w >> 32)); ms += mt[t]; }
            const float mean = ms * 0.25f; float q = 0.f;
#pragma unroll
            for (int t = 0; t < 4; ++t) { const float dm = mt[t] - mean; q += m2[t] + 256.0f * dm * dm; }
            S[row] = (f32x2v){mean, 1.0f / sqrtf(q * (1.0f / 1024.0f) + eps)};
        }
        asm volatile("s_waitcnt lgkmcnt(0)" ::: "memory"); __builtin_amdgcn_s_barrier(); asm volatile("" ::: "memory");
    }
};
struct EpiLnRouter {
    static constexpr bool PERM = true, AFTER_DRAIN = true;
    __device__ __forceinline__ bool keep(const pg8::Unit&) const { return false; }
    const float* x; bf16* X1B; const float* lg; const float* lb; const bf16* WRH; const bf16* WRL; float* PLG; PanelStats st;
    __device__ __forceinline__ void fused(f32x4 (&acc)[2][2][4][2], const pg8::Unit& u, int wr, int wc, int fr_, int fq_, LAS unsigned char* lds, int wid, int lane) const {
        int fr = fr_, fq = fq_; asm volatile("" : "+v"(fr), "+v"(fq));
        const int row0 = u.pm * 256 + wr * 64 + fr, col0 = u.pn * 256 + wc * 32 + 8 * fq;
        { f32x4 xv[2][2][2][2];
#define LNR_LOAD(P_) do { _Pragma("unroll") for (int mm = 0; mm < 2; ++mm) { const size_t o = (size_t)(row0 + ((P_) >> 1) * 128 + (2 * ((P_) & 1) + mm) * 16) * 1024 + col0; \
            _Pragma("unroll") for (int bj = 0; bj < 2; ++bj) { xv[(P_) & 1][mm][bj][0] = __builtin_nontemporal_load((const f32x4*)(x + o + bj * 128)); xv[(P_) & 1][mm][bj][1] = __builtin_nontemporal_load((const f32x4*)(x + o + bj * 128 + 4)); } } } while (0)
          LNR_LOAD(0);
#pragma unroll
          for (int p = 0; p < 4; ++p) { const int ai = p >> 1;
              if (p + 1 < 4) LNR_LOAD(p + 1);
#pragma unroll
              for (int mm = 0; mm < 2; ++mm) { const int m = 2 * (p & 1) + mm;
#pragma unroll
                  for (int bj = 0; bj < 2; ++bj) { acc[ai][bj][m][0] = xv[p & 1][mm][bj][0] * DN_ALPHA + acc[ai][bj][m][0]; acc[ai][bj][m][1] = xv[p & 1][mm][bj][1] * DN_ALPHA + acc[ai][bj][m][1]; }
                  asm volatile("" : "+v"(acc[ai][0][m][0]), "+v"(acc[ai][0][m][1]), "+v"(acc[ai][1][m][0]), "+v"(acc[ai][1][m][1])); }
              asm volatile("" ::: "memory"); }
#undef LNR_LOAD
        }
        st.run(acc, u, wr, wc, fr, fq, lds, wid, lane);
        asm volatile("" : "+v"(fr), "+v"(fq));
        const int col1 = u.pn * 256 + wc * 32 + 8 * fq;
        const LAS f32x2v* S = (const LAS f32x2v*)(lds + 8192);
        LAS float* PL = (LAS float*)(lds + 16384);
        const int tid = wid * 64 + lane;
        f32x4 gv[2][2], bv[2][2]; bf16x8 whv[2][3], wlv[2][3];
#pragma unroll
        for (int bj = 0; bj < 2; ++bj) { const int gc = col1 + bj * 128;
            gv[bj][0] = *(const f32x4*)(lg + gc); gv[bj][1] = *(const f32x4*)(lg + gc + 4); bv[bj][0] = *(const f32x4*)(lb + gc); bv[bj][1] = *(const f32x4*)(lb + gc + 4);
#pragma unroll
            for (int nt = 0; nt < 3; ++nt) { whv[bj][nt] = *(const bf16x8*)(WRH + (size_t)(nt * 16 + fr) * 1024 + gc); wlv[bj][nt] = *(const bf16x8*)(WRL + (size_t)(nt * 16 + fr) * 1024 + gc); } }
        __builtin_amdgcn_sched_barrier(0);
#pragma unroll
        for (int ai = 0; ai < 2; ++ai) {
#pragma unroll
            for (int m = 0; m < 4; ++m) {
                const int r = ai * 128 + wr * 64 + m * 16 + fr; const f32x2v sr = S[r];
                f32x4 la[3] = {{0.f, 0.f, 0.f, 0.f}, {0.f, 0.f, 0.f, 0.f}, {0.f, 0.f, 0.f, 0.f}};
#pragma unroll
                for (int bj = 0; bj < 2; ++bj) { const int gc = col1 + bj * 128;
                    const f32x4 g0 = gv[bj][0], g1 = gv[bj][1], b0 = bv[bj][0], b1 = bv[bj][1];
                    const f32x4 y0 = (acc[ai][bj][m][0] - sr.x) * sr.y * g0 + b0, y1 = (acc[ai][bj][m][1] - sr.x) * sr.y * g1 + b1;
                    union { bf16x8 v; unsigned u[4]; } xh, xl;
                    xh.u[0] = pk2(y0[0], y0[1]); xh.u[1] = pk2(y0[2], y0[3]); xh.u[2] = pk2(y1[0], y1[1]); xh.u[3] = pk2(y1[2], y1[3]);
                    *(u32x4*)(X1B + (size_t)(u.pm * 256 + r) * 1024 + gc) = (u32x4){xh.u[0], xh.u[1], xh.u[2], xh.u[3]};
                    xl.u[0] = pk2(y0[0] - bflo(xh.u[0]), y0[1] - bfhi(xh.u[0])); xl.u[1] = pk2(y0[2] - bflo(xh.u[1]), y0[3] - bfhi(xh.u[1]));
                    xl.u[2] = pk2(y1[0] - bflo(xh.u[2]), y1[1] - bfhi(xh.u[2])); xl.u[3] = pk2(y1[2] - bflo(xh.u[3]), y1[3] - bfhi(xh.u[3]));
#pragma unroll
                    for (int nt = 0; nt < 3; ++nt) { const bf16x8 wh = whv[bj][nt], wl = wlv[bj][nt];
                        la[nt] = __builtin_amdgcn_mfma_f32_16x16x32_bf16(xh.v, wh, la[nt], 0, 0, 0);
                        la[nt] = __builtin_amdgcn_mfma_f32_16x16x32_bf16(xh.v, wl, la[nt], 0, 0, 0);
                        la[nt] = __builtin_amdgcn_mfma_f32_16x16x32_bf16(xl.v, wh, la[nt], 0, 0, 0); }
                    asm volatile("" ::: "memory"); }
#pragma unroll
                for (int nt = 0; nt < 3; ++nt)
#pragma unroll
                    for (int i = 0; i < 4; ++i) PL[(wc * 128 + wr * 64 + m * 16 + 4 * fq + i) * 52 + nt * 16 + fr] = la[nt][i];
                asm volatile("" ::: "memory"); }
            __syncthreads();
            for (int idx = tid; idx < 128 * 36; idx += NTHR) { const int rr = idx / 36, e = idx - rr * 36;
                const float s = (PL[rr * 52 + e] + PL[(128 + rr) * 52 + e]) + (PL[(256 + rr) * 52 + e] + PL[(384 + rr) * 52 + e]);
                float* pp = PLG + ((size_t)(u.pm * 256 + ai * 128 + rr) * 4 + u.pn) * 36 + e;
                asm volatile("global_store_dword %0, %1, off sc1\n\ts_nop 1" :: "v"(pp), "v"(s) : "memory"); }
            __syncthreads();
        }
    }
};
struct P1Order {
    pg8::StaticOrder so; const bf16* memA; const bf16* memB;
    __device__ __forceinline__ bool next(int i, pg8::Unit& u) const {
        const long L = (long)i * so.G + so.c; if (L < so.nwg) return so.next(i, u);
        const int k = (int)(L - so.nwg); if (k >= 32) return false; u.pm = k & 7; u.pn = 100 + (k >> 3); return true; }
    static constexpr bool GATHER = false, HALFM = false;
    __device__ __forceinline__ unsigned rowoff(const pg8::Unit&, int) const { return 0u; }
    __device__ __forceinline__ void a_ready(const pg8::Unit&) const {}
    __device__ __forceinline__ void done(const pg8::Unit&) const {}
    __device__ __forceinline__ const char* pa(const pg8::Gemm& g, const pg8::Unit& u, size_t tstep) const { return u.pn >= 100 ? (const char*)memA + (size_t)u.pm * tstep : (const char*)g.A + (size_t)u.pm * tstep; }
    __device__ __forceinline__ const char* pb(const pg8::Gemm& g, const pg8::Unit& u, size_t tstep) const { return u.pn >= 100 ? (const char*)memB + (size_t)(u.pn - 100) * tstep : (const char*)g.Bt + (size_t)u.pn * tstep; }
};
__device__ __forceinline__ void nsa_gates(const bf16* XB, const bf16* WG, float* NG, LAS unsigned char* lds, int vcu, int G, int tid) {
    const int lane = tid & 63, wave = tid >> 6, c = lane & 15, q4 = lane >> 4, kh = wave >> 2;
    constexpr int WP = 2048 + 16;
    LAS unsigned char* wl_ = lds + LDS_WORK + 8192;
    LAS f32x4* xch = (LAS f32x4*)(lds + LDS_WORK);
    bool staged = false;
    for (int blk = vcu; blk < T / 64; blk += G) { const int rt = blk * 4 + (wave & 3);
        bf16x8 fa[16];
#pragma unroll
        for (int j = 0; j < 16; ++j) fa[j] = *(const bf16x8*)(XB + (size_t)(rt * 16 + c) * 1024 + 32 * (16 * kh + j) + 8 * q4);
        if (!staged) { u32x4 wv_[8];
#pragma unroll
            for (int i = 0; i < 8; ++i) { const int id = tid + NTHR * i; wv_[i] = *(const u32x4*)((const unsigned char*)WG + (size_t)id * 16); }
#pragma unroll
            for (int i = 0; i < 8; ++i) { const int id = tid + NTHR * i, row = id >> 7, ch = id & 127; *(LAS u32x4*)(wl_ + row * WP + ch * 16) = wv_[i]; }
            __syncthreads(); staged = true; }
        f32x4 acc[2] = {{0.f, 0.f, 0.f, 0.f}, {0.f, 0.f, 0.f, 0.f}};
#pragma unroll
        for (int j = 0; j < 16; ++j) { const int ks = 16 * kh + j;
            const bf16x8 b0 = *(const LAS bf16x8*)(wl_ + c * WP + (32 * ks + 8 * q4) * 2), b1 = *(const LAS bf16x8*)(wl_ + (16 + c) * WP + (32 * ks + 8 * q4) * 2);
            acc[0] = __builtin_amdgcn_mfma_f32_16x16x32_bf16(fa[j], b0, acc[0], 0, 0, 0); acc[1] = __builtin_amdgcn_mfma_f32_16x16x32_bf16(fa[j], b1, acc[1], 0, 0, 0); }
        if (kh) { xch[((wave & 3) * 2 + 0) * 64 + lane] = acc[0]; xch[((wave & 3) * 2 + 1) * 64 + lane] = acc[1]; }
        __syncthreads();
        if (!kh) {
#pragma unroll
            for (int nb = 0; nb < 2; ++nb) { const f32x4 o = xch[((wave & 3) * 2 + nb) * 64 + lane];
#pragma unroll
                for (int r = 0; r < 4; ++r) if (16 * nb + c < 24) NG[(size_t)(rt * 16 + 4 * q4 + r) * 32 + 16 * nb + c] = sigmoidf_(acc[nb][r] + o[r]); } }
        __syncthreads();
    }
}
#define XB_TMO      128
#define XB_XCNT(j)  (256  + 64 * (j))
#define XB_XSUB(j)  (1280 + 64 * (j))
#define XB_XGEN(j)  (2304 + 64 * (j))
#define XB_TOP      3328
#define XB_TOPGEN   3392
#define XCD_BAR_WORDS 3456
#define XB_SPIN_CAP (1u << 18)

__device__ __forceinline__ unsigned xb_ld(unsigned* p)              { return __hip_atomic_load(p, __ATOMIC_RELAXED, __HIP_MEMORY_SCOPE_AGENT); }
__device__ __forceinline__ unsigned xb_add(unsigned* p, unsigned v) { return __hip_atomic_fetch_add(p, v, __ATOMIC_RELAXED, __HIP_MEMORY_SCOPE_AGENT); }
__device__ __forceinline__ unsigned xb_xcc_id() { return (unsigned)__builtin_amdgcn_s_getreg((3 << 11) | 20) & 0xFu; }
#define XB_SPIN(cond, bar) do { unsigned _sp = 0; while (cond) { __builtin_amdgcn_s_sleep(1); \
    if ((++_sp & 255u) == 0u) { if (xb_ld(&(bar)[XB_TMO])) break; if (_sp > XB_SPIN_CAP) { atomicAdd(&(bar)[XB_TMO], 1u); break; } } } } while (0)

struct XcdBarrier {
    unsigned* bar; unsigned x; int wv;
    volatile LAS unsigned* st;
};

__device__ __forceinline__ XcdBarrier xcd_barrier_post(unsigned* bar, volatile LAS unsigned* st, int wv) {
    XcdBarrier b; b.bar = bar; b.x = xb_xcc_id(); b.st = st; b.wv = wv;
    if (wv == 0 && lane_id() == 0) (void)xb_add(&bar[XB_XCNT(b.x)], 1u);
    return b;
}
__device__ __forceinline__ void xcd_barrier_complete(unsigned* bar, unsigned x, unsigned& nloc, unsigned& nx) {
    const unsigned G = gridDim.x * gridDim.y * gridDim.z;
    unsigned sum, cnt, mine, sp = 0u;
    for (;;) {
        sum = 0u; cnt = 0u; mine = 0u;
#pragma unroll
        for (unsigned j = 0; j < 16; ++j) { const unsigned c = xb_ld(&bar[XB_XCNT(j)]); sum += c; cnt += (c > 0u) ? 1u : 0u; mine = (j == x) ? c : mine; }
        if (sum == G) break;
        __builtin_amdgcn_s_sleep(1);
        if ((++sp & 255u) == 0u) { if (xb_ld(&bar[XB_TMO])) break; if (sp > XB_SPIN_CAP) { atomicAdd(&bar[XB_TMO], 1u); break; } }
    }
    nloc = mine > 0u ? mine : 1u; nx = cnt > 0u ? cnt : 1u;
}

__device__ __forceinline__ void xcd_barrier(const XcdBarrier& b) {
    asm volatile("s_waitcnt vmcnt(0)" ::: "memory");
    __syncthreads();
    if (b.wv == 0 && lane_id() == 0) {
        unsigned* bar = b.bar;
        __builtin_amdgcn_s_waitcnt(0);
        unsigned nloc = b.st[0], nx = b.st[1];
        if (nloc == 0u) { xcd_barrier_complete(bar, b.x, nloc, nx); b.st[0] = nloc; b.st[1] = nx; }
        const unsigned old = xb_add(&bar[XB_XSUB(b.x)], 1u);
        const unsigned gen = old / nloc;
        if (old + 1u == (gen + 1u) * nloc) {
            __builtin_amdgcn_fence(__ATOMIC_RELEASE, "agent");
            asm volatile("s_waitcnt vmcnt(0)" ::: "memory");
            const unsigned og = xb_add(&bar[XB_TOP], 1u);
            const unsigned tg = og / nx;
            if (og + 1u == (tg + 1u) * nx) xb_add(&bar[XB_TOPGEN], 1u);
            else XB_SPIN(xb_ld(&bar[XB_TOPGEN]) == tg, bar);
            __builtin_amdgcn_fence(__ATOMIC_ACQUIRE, "agent");
            xb_add(&bar[XB_XGEN(b.x)], 1u);
            asm volatile("s_waitcnt vmcnt(0)" ::: "memory");
        } else {
            XB_SPIN(xb_ld(&bar[XB_XGEN(b.x)]) == gen, bar);
            __builtin_amdgcn_fence(__ATOMIC_ACQUIRE, "agent");
            asm volatile("s_waitcnt vmcnt(0)" ::: "memory");
        }
    }
    __syncthreads();
}
template <int D> struct ATile { static constexpr int PITCH = (D + 16) * 2, BYTES = 64 * PITCH, NL = D / 64; };
typedef short v4i16_t __attribute__((ext_vector_type(4)));
__device__ __forceinline__ s16x4 tr16(const LAS char* p) { return __builtin_bit_cast(s16x4, __builtin_amdgcn_ds_read_tr16_b64_v4i16((LAS v4i16_t*)p)); }

template <int D> __device__ __forceinline__ void tile_load(const bf16* base, size_t pitch, int tid, u32x4 (&r)[D / 64]) {
    constexpr int NCH = D / 8;
#pragma unroll
    for (int i = 0; i < D / 64; ++i) { const int id = tid + NTHR * i, row = id / NCH, ch = id % NCH; r[i] = *(const u32x4*)(base + (size_t)row * pitch + ch * 8); }
}
template <int D> __device__ __forceinline__ void tile_store(LAS char* dst, int tid, const u32x4 (&r)[D / 64]) {
    constexpr int NCH = D / 8;
#pragma unroll
    for (int i = 0; i < D / 64; ++i) { const int id = tid + NTHR * i, row = id / NCH, ch = id % NCH; *(LAS u32x4*)(dst + row * ATile<D>::PITCH + ch * 16) = r[i]; }
}

constexpr float DEFER_THR = 6.0f;
constexpr float M_INIT = -64.0f;
template <int D, int NCG, class MF>
__device__ __forceinline__ void attn_tile(const LAS char* Kt, const LAS char* Vt, const bf16x8 (&qf)[NCG][D / 32], f32x4 (&acc)[NCG][D / 16], float (&mrun)[NCG], float (&lrun)[NCG],
                                          int kpos0, int mode, bool lanepred, const MF& mf, int lane) {
    constexpr int P = ATile<D>::PITCH;
    const int c = lane & 15, q4 = lane >> 4;
    const bool off = (mode == 1) && !lanepred;
    f32x4 s0[2][NCG], s1[2][NCG], negm[NCG];
#pragma unroll
    for (int cg = 0; cg < NCG; ++cg) { const float nm = off ? -__builtin_inff() : -mrun[cg]; negm[cg] = (f32x4){nm, nm, nm, nm}; }
    __builtin_amdgcn_s_setprio(1);
#pragma unroll
    for (int s = 0; s < 2; ++s) {
        bf16x8 kf[2][D / 32];
#pragma unroll
        for (int h = 0; h < 2; ++h)
#pragma unroll
            for (int ks = 0; ks < D / 32; ++ks) kf[h][ks] = *(const LAS bf16x8*)(Kt + (32 * s + 16 * h + c) * P + (32 * ks + 8 * q4) * 2);
#pragma unroll
        for (int cg = 0; cg < NCG; ++cg) { s0[s][cg] = negm[cg]; s1[s][cg] = negm[cg];
#pragma unroll
            for (int ks = 0; ks < D / 32; ++ks) { s0[s][cg] = __builtin_amdgcn_mfma_f32_16x16x32_bf16(kf[0][ks], qf[cg][ks], s0[s][cg], 0, 0, 0); s1[s][cg] = __builtin_amdgcn_mfma_f32_16x16x32_bf16(kf[1][ks], qf[cg][ks], s1[s][cg], 0, 0, 0); } }
    }
    __builtin_amdgcn_s_setprio(0);
    if (mode == 2) {
#pragma unroll
        for (int s = 0; s < 2; ++s) { const int kb = kpos0 + 32 * s + 4 * q4;
#pragma unroll
            for (int r = 0; r < 4; ++r) { const bool a = mf.valid(kb + r), b = mf.valid(kb + 16 + r);
#pragma unroll
                for (int cg = 0; cg < NCG; ++cg) { s0[s][cg][r] = a ? s0[s][cg][r] : -__builtin_inff(); s1[s][cg][r] = b ? s1[s][cg][r] : -__builtin_inff(); } } } }
    bf16x8 vf0[D / 16];
#pragma unroll
    for (int db = 0; db < D / 16; ++db) { const LAS char* vp = Vt + (4 * q4 + (c >> 2)) * P + (16 * db + 4 * (c & 3)) * 2;
        const s16x4 lo = tr16(vp), hi = tr16(vp + 16 * P); vf0[db] = (bf16x8){lo[0], lo[1], lo[2], lo[3], hi[0], hi[1], hi[2], hi[3]}; }
    float lm[NCG]; bool grow = false;
#pragma unroll
    for (int cg = 0; cg < NCG; ++cg) {
        int mi = (int)0x80000000;
#pragma unroll
        for (int s = 0; s < 2; ++s)
#pragma unroll
            for (int r = 0; r < 4; ++r) { const int a = __builtin_bit_cast(int, s0[s][cg][r]), b = __builtin_bit_cast(int, s1[s][cg][r]); mi = mi > a ? mi : a; mi = mi > b ? mi : b; }
        const float m = __builtin_bit_cast(float, mi);
        lm[cg] = m; grow = grow || (mi > __builtin_bit_cast(int, DEFER_THR)); }
    if (__builtin_amdgcn_ballot_w64(grow) != 0ull) {
#pragma unroll
        for (int cg = 0; cg < NCG; ++cg) { const float d = fmaxf(xrow16_max(lm[cg]), 0.f), alpha = fast_exp2(-d);
            mrun[cg] += d; lrun[cg] *= alpha;
#pragma unroll
            for (int db = 0; db < D / 16; ++db) acc[cg][db] = acc[cg][db] * alpha;
#pragma unroll
            for (int s = 0; s < 2; ++s) { s0[s][cg] = s0[s][cg] - d; s1[s][cg] = s1[s][cg] - d; } }
    }
    bf16x8 pfv[2][NCG];
#define AT_EXPS(S_) _Pragma("unroll") for (int cg = 0; cg < NCG; ++cg) { float p0[4], p1[4]; \
            _Pragma("unroll") for (int r = 0; r < 4; ++r) { p0[r] = fast_exp2(s0[S_][cg][r]); p1[r] = fast_exp2(s1[S_][cg][r]); } \
            union { bf16x8 v; unsigned u[4]; } pf; \
            pf.u[0] = pg8::cvt_pk_bf16(p0[0], p0[1]); pf.u[1] = pg8::cvt_pk_bf16(p0[2], p0[3]); pf.u[2] = pg8::cvt_pk_bf16(p1[0], p1[1]); pf.u[3] = pg8::cvt_pk_bf16(p1[2], p1[3]); \
            pfv[S_][cg] = pf.v; }
    AT_EXPS(0)
    const bf16x8 ones = {0x3F80, 0x3F80, 0x3F80, 0x3F80, 0x3F80, 0x3F80, 0x3F80, 0x3F80};
    f32x4 lt[NCG];
    bf16x8 vf1[D / 16];
    __builtin_amdgcn_sched_barrier(0);
#pragma unroll
    for (int cg = 0; cg < NCG; ++cg) { lt[cg] = __builtin_amdgcn_mfma_f32_16x16x32_bf16(ones, pfv[0][cg], (f32x4){0.f, 0.f, 0.f, 0.f}, 0, 0, 0);
#pragma unroll
        for (int db = 0; db < D / 16; ++db) acc[cg][db] = __builtin_amdgcn_mfma_f32_16x16x32_bf16(vf0[db], pfv[0][cg], acc[cg][db], 0, 0, 0); }
#pragma unroll
    for (int db = 0; db < D / 16; ++db) { const LAS char* vp = Vt + (32 + 4 * q4 + (c >> 2)) * P + (16 * db + 4 * (c & 3)) * 2;
        const s16x4 lo = tr16(vp), hi = tr16(vp + 16 * P); vf1[db] = (bf16x8){lo[0], lo[1], lo[2], lo[3], hi[0], hi[1], hi[2], hi[3]}; }
    AT_EXPS(1)
#pragma unroll
    for (int i = 0; i < NCG * (D / 16 + 1); ++i) { __builtin_amdgcn_sched_group_barrier(0x008, 1, 0); __builtin_amdgcn_sched_group_barrier(0x402, 4, 0); }
    __builtin_amdgcn_sched_barrier(0);
#undef AT_EXPS
    __builtin_amdgcn_s_setprio(1);
#pragma unroll
    for (int cg = 0; cg < NCG; ++cg) { lt[cg] = __builtin_amdgcn_mfma_f32_16x16x32_bf16(ones, pfv[1][cg], lt[cg], 0, 0, 0); lrun[cg] += 0.25f * lt[cg][0];
#pragma unroll
        for (int db = 0; db < D / 16; ++db) acc[cg][db] = __builtin_amdgcn_mfma_f32_16x16x32_bf16(vf1[db], pfv[1][cg], acc[cg][db], 0, 0, 0); }
    __builtin_amdgcn_s_setprio(0);
}

template <int D, int NCG, int TPI, class MF>
__device__ __forceinline__ void attn_loop(LAS char* buf, const bf16* Kb, const bf16* Vb, size_t pitch, int t_lo, int t_hi, const MF& mf,
                                          const bf16x8 (&qf)[NCG][D / 32], f32x4 (&acc)[NCG][D / 16], float (&mrun)[NCG], float (&lrun)[NCG], int tid, int lane) {
    constexpr int TB = ATile<D>::BYTES, BUFB = 2 * TPI * TB;
    u32x4 ka[TPI][D / 64], va[TPI][D / 64], kb[TPI][D / 64], vb[TPI][D / 64];
#define ATT_LOAD(K_, V_, T0) do { _Pragma("unroll") for (int i = 0; i < TPI; ++i) if ((T0) + i <= t_hi) { tile_load<D>(Kb + (size_t)((T0) + i) * 64 * pitch, pitch, tid, K_[i]); tile_load<D>(Vb + (size_t)((T0) + i) * 64 * pitch, pitch, tid, V_[i]); } } while (0)
#define ATT_STORE(K_, V_, T0, B_) do { _Pragma("unroll") for (int i = 0; i < TPI; ++i) if ((T0) + i <= t_hi) { tile_store<D>((B_) + i * TB, tid, K_[i]); tile_store<D>((B_) + (TPI + i) * TB, tid, V_[i]); } } while (0)
#define ATT_COMP(T0, B_) do { _Pragma("unroll") for (int i = 0; i < TPI; ++i) if ((T0) + i <= t_hi && !mf.skip((T0) + i)) \
        attn_tile<D, NCG, MF>((B_) + i * TB, (B_) + (TPI + i) * TB, qf, acc, mrun, lrun, ((T0) + i) * 64, mf.mode((T0) + i), mf.lanepred((T0) + i), mf, lane); } while (0)
    ATT_LOAD(ka, va, t_lo); ATT_STORE(ka, va, t_lo, buf);
    ATT_LOAD(ka, va, t_lo + TPI);
    __syncthreads();
    for (int t = t_lo; t <= t_hi; t += 2 * TPI) {
        ATT_LOAD(kb, vb, t + 2 * TPI);
        ATT_COMP(t, buf);
        ATT_STORE(ka, va, t + TPI, buf + BUFB);
        __syncthreads();
        if (t + TPI > t_hi) break;
        ATT_LOAD(ka, va, t + 3 * TPI);
        ATT_COMP(t + TPI, buf + BUFB);
        ATT_STORE(kb, vb, t + 2 * TPI, buf);
        __syncthreads();
    }
#undef ATT_LOAD
#undef ATT_STORE
#undef ATT_COMP
}

struct MaskU { int qpos, lowb; __device__ __forceinline__ bool valid(int k) const { return k <= qpos && k > lowb; } };
template <int D> struct NsaStream { const bf16* Kb0; const bf16* Vb0; const bf16* Kb1; const bf16* Vb1; size_t pitch; int n0, lo1, ntot;
    template <int TPI> __device__ __forceinline__ void load(int v0, u32x4 (&K_)[TPI][D / 64], u32x4 (&V_)[TPI][D / 64], int tid) const {
#pragma unroll
        for (int i = 0; i < TPI; ++i) { const int v = v0 + i; if (v < ntot) { const bool s1 = v >= n0; const int t = s1 ? lo1 + (v - n0) : v; const bf16* kp = s1 ? Kb1 : Kb0; const bf16* vp = s1 ? Vb1 : Vb0;
            tile_load<D>(kp + (size_t)t * 64 * pitch, pitch, tid, K_[i]); tile_load<D>(vp + (size_t)t * 64 * pitch, pitch, tid, V_[i]); } } }
    template <int TPI> __device__ __forceinline__ void store(int v0, LAS char* B_, const u32x4 (&K_)[TPI][D / 64], const u32x4 (&V_)[TPI][D / 64], int tid) const {
#pragma unroll
        for (int i = 0; i < TPI; ++i) if (v0 + i < ntot) { tile_store<D>(B_ + i * ATile<D>::BYTES, tid, K_[i]); tile_store<D>(B_ + (TPI + i) * ATile<D>::BYTES, tid, V_[i]); } }
};
template <int D, int NCG, int TPI, class FIN>
__device__ __forceinline__ void attn_loop2(LAS char* buf, const NsaStream<D>& st, int qpos, int q0, int q64, unsigned sel, const bf16x8 (&qf)[NCG][D / 32], f32x4 (&acc)[NCG][D / 16], float (&mrun)[NCG], float (&lrun)[NCG],
                                           const FIN& fin, u32x4 (&ka)[TPI][D / 64], u32x4 (&va)[TPI][D / 64], int tid, int lane) {
    constexpr int TB = ATile<D>::BYTES, BUFB = 2 * TPI * TB;
    u32x4 kb[TPI][D / 64], vb[TPI][D / 64];
#define ATT2_COMP(V0, B_) do { _Pragma("unroll") for (int i = 0; i < TPI; ++i) { const int v_ = (V0) + i; if (v_ < st.ntot) { if (v_ == st.n0) fin(acc, mrun, lrun); \
        const bool s1_ = v_ >= st.n0; const int t_ = s1_ ? st.lo1 + (v_ - st.n0) : v_; \
        const int mode_ = s1_ ? ((64 * t_ + 63 <= q0 && 64 * t_ >= q0 + 15 - 511) ? 0 : 2) : (t_ < q64 ? 1 : 2); const bool lp_ = s1_ ? true : (((sel >> t_) & 1u) != 0u); \
        const MaskU mf_{qpos, s1_ ? qpos - 512 : -(1 << 30)}; \
        attn_tile<D, NCG, MaskU>((B_) + i * TB, (B_) + (TPI + i) * TB, qf, acc, mrun, lrun, t_ * 64, mode_, lp_, mf_, lane); } } } while (0)
    for (int v = 0; v < st.ntot; v += 2 * TPI) {
        st.template load<TPI>(v + 2 * TPI, kb, vb, tid);
        ATT2_COMP(v, buf);
        st.template store<TPI>(v + TPI, buf + BUFB, ka, va, tid);
        __syncthreads();
        if (v + TPI >= st.ntot) break;
        st.template load<TPI>(v + 3 * TPI, ka, va, tid);
        ATT2_COMP(v + TPI, buf + BUFB);
        st.template store<TPI>(v + 2 * TPI, buf, kb, vb, tid);
        __syncthreads();
    }
#undef ATT2_COMP
}

template <int D, int NCG, int NT, class MF>
__device__ __forceinline__ void attn_all(LAS char* buf, const bf16* Kb, const bf16* Vb, size_t pitch, const MF& mf,
                                         const bf16x8 (&qf)[NCG][D / 32], f32x4 (&acc)[NCG][D / 16], float (&mrun)[NCG], float (&lrun)[NCG], int tid, int lane) {
    constexpr int TB = ATile<D>::BYTES;
    u32x4 rk[NT][D / 64], rv[NT][D / 64];
#pragma unroll
    for (int i = 0; i < NT; ++i) { tile_load<D>(Kb + (size_t)i * 64 * pitch, pitch, tid, rk[i]); tile_load<D>(Vb + (size_t)i * 64 * pitch, pitch, tid, rv[i]); }
#pragma unroll
    for (int i = 0; i < NT; ++i) { tile_store<D>(buf + i * TB, tid, rk[i]); tile_store<D>(buf + (NT + i) * TB, tid, rv[i]); }
    __syncthreads();
#pragma unroll 1
    for (int i = 0; i < NT; ++i) attn_tile<D, NCG, MF>(buf + i * TB, buf + (NT + i) * TB, qf, acc, mrun, lrun, i * 64, 0, false, mf, lane);
    __syncthreads();
}
struct Args {
    const float* in[29]; float* out; unsigned char* ws; int ph_lo, ph_hi, sub, pad;
};
enum { I_X = 0, I_MEM, I_WIN, I_PEK, I_W1K, I_W2K, I_PEV, I_W1V, I_W2V, I_SLNG, I_SLNB, I_SWS, I_SBS, I_WMEMKV, I_WBRN, I_WBRS, I_WBRM, I_WO, I_LN1G, I_LN1B,
       I_WRG, I_BRG, I_WRE, I_BRE, I_WEG, I_WEU, I_WED, I_LN2G, I_LN2B };

template <bool FRAG = false>
__device__ __forceinline__ void tr_item(const float* W, int ldw, int k0, int col0, int ncols, bf16* WT, int ldt, int row0, LAS float* scr, int lane) {
#pragma unroll
    for (int i = 0; i < 8; ++i) { const int kk = 8 * i + (lane >> 3), n4 = (lane & 7) * 4;
        const f32x4 v = n4 < ncols ? __builtin_nontemporal_load((const f32x4*)(W + (size_t)(k0 + kk) * ldw + col0 + n4)) : (f32x4){0.f, 0.f, 0.f, 0.f};
        LAS float* d = scr + kk * 33 + n4; d[0] = v[0]; d[1] = v[1]; d[2] = v[2]; d[3] = v[3]; }
    LDS_WAIT(); asm volatile("" ::: "memory");
    const int c = lane & 7;
#pragma unroll
    for (int j = 0; j < 4; ++j) { const int n = (lane >> 3) + 8 * j; const LAS float* s = scr + (8 * c) * 33 + n;
        u32x4 o; o.x = pg8::cvt_pk_bf16(s[0 * 33], s[1 * 33]); o.y = pg8::cvt_pk_bf16(s[2 * 33], s[3 * 33]); o.z = pg8::cvt_pk_bf16(s[4 * 33], s[5 * 33]); o.w = pg8::cvt_pk_bf16(s[6 * 33], s[7 * 33]);
        if constexpr (FRAG) { const int N = row0 + n, k = k0 + 8 * c; *(u32x4*)(WT + (size_t)((((N >> 4) * 64 + (k >> 5)) * 64) + ((k >> 3) & 3) * 16 + (N & 15)) * 8) = o; }
        else *(u32x4*)(WT + (size_t)(row0 + n) * ldt + k0 + 8 * c) = o; }
    LDS_WAIT(); asm volatile("" ::: "memory");
}
template <bool FRAG = false>
__device__ __forceinline__ bool tr_job(int& it, const float* W, int ldw, int K, int col0, int ncols, bf16* WT, int row0, LAS float* scr, int lane) {
    const int nb = (ncols + 31) / 32, n_items = (K / 64) * nb;
    if (it >= n_items) { it -= n_items; return false; }
    const int kb = it / nb, b = it % nb; const int rem = ncols - 32 * b;
    tr_item<FRAG>(W, ldw, 64 * kb, col0 + 32 * b, rem < 32 ? rem : 32, WT, K, row0 + 32 * b, scr, lane);
    return true;
}
__device__ __forceinline__ void cvt_rows_bf16(const float* src, bf16* dst, size_t n8, int gtid, int gthreads) {
    for (size_t i = gtid; i < n8; i += gthreads) { const f32x4 a = __builtin_nontemporal_load((const f32x4*)src + 2 * i), b = __builtin_nontemporal_load((const f32x4*)src + 2 * i + 1);
        u32x4 o; o.x = pg8::cvt_pk_bf16(a[0], a[1]); o.y = pg8::cvt_pk_bf16(a[2], a[3]); o.z = pg8::cvt_pk_bf16(b[0], b[1]); o.w = pg8::cvt_pk_bf16(b[2], b[3]); ((u32x4*)dst)[i] = o; }
}
__device__ __forceinline__ void p0_prologue(const Args& A, LAS unsigned char* lds, int vcu, int G, int wv) {
    const int tid = opaque_tid(wv), lane = tid & 63, wave = tid >> 6;
    unsigned char* ws = A.ws;
    LAS float* scr = (LAS float*)(lds + LDS_WORK + wave * 16384);
    const int gw = vcu * NWAVES + wave, NGW = G * NWAVES;
    bf16* WINT = (bf16*)(ws + WS_WINT);
    constexpr int N_ITEMS = 16 * (40 + 32 + 16 + 96 + 1) + 16 * 32;
    for (int it0 = gw; it0 < N_ITEMS; it0 += NGW) {
        int it = it0;
        if (tr_job(it, A.in[I_WIN], IN_W, 1024, S_Q, 1280, WINT, C_Q, scr, lane)) continue;
        if (tr_job(it, A.in[I_WIN], IN_W, 1024, S_SGU, 1024, WINT, C_SGU, scr, lane)) continue;
        if (tr_job(it, A.in[I_WIN], IN_W, 1024, S_MQ, 512, WINT, C_MQ, scr, lane)) continue;
        if (tr_job(it, A.in[I_WIN], IN_W, 1024, S_MG, 3072, WINT, C_MG, scr, lane)) continue;
        if (tr_job(it, A.in[I_WIN], IN_W, 1024, S_NG, 24, WINT, C_NG, scr, lane)) continue;
        tr_job(it, A.in[I_WMEMKV], 1024, 1024, 0, 1024, (bf16*)(ws + WS_WMEMT), 0, scr, lane);
    }
    const int gtid = vcu * NTHR + tid, gthreads = G * NTHR;
    for (int i = gtid; i < 224 * 1024 / 8; i += gthreads) ((u32x4*)(WINT + (size_t)5920 * 1024))[i] = (u32x4){0u, 0u, 0u, 0u};
    cvt_rows_bf16(A.in[I_X], (bf16*)(ws + WS_XBF), (size_t)T * DM / 8, gtid, gthreads);
    cvt_rows_bf16(A.in[I_MEM], (bf16*)(ws + WS_MEMBF), (size_t)NB * 256 * DM / 8, gtid, gthreads);
    for (int i = gtid; i < 8 * 128 * 128; i += gthreads) { const int s = i & 127, t = (i >> 7) & 127; ((bf16*)(ws + WS_SGUW))[i] = (bf16)(s <= t ? f2bf(A.in[I_SWS][i]) : 0u); }
    for (int i = gtid; i < 48 * 1024; i += gthreads) { const int o = i >> 10, k = i & 1023; const float w = o < 4 ? A.in[I_WRG][k * 4 + o] : o < 36 ? A.in[I_WRE][k * 32 + o - 4] : 0.f;
        const unsigned h = f2bf(w); ((bf16*)(ws + WS_WRH))[i] = (bf16)h; ((bf16*)(ws + WS_WRL))[i] = (bf16)f2bf(w - bf2f(h)); }
    for (int i = gtid; i < SEQ * 8; i += gthreads) { const int pos = i >> 3, k = i & 7;
        const float inv = (float)pow(500000.0, -(double)k / 8.0); const float ang = (float)pos * inv;
        ((f32x2*)(ws + WS_ROPE))[i] = (f32x2){(float)cos((double)ang), (float)sin((double)ang)}; }
}
__device__ __forceinline__ void p0_late(const Args& A, LAS unsigned char* lds, int li, int NL, int wv) {
    const int tid = opaque_tid(wv), lane = tid & 63, wave = tid >> 6;
    unsigned char* ws = A.ws;
    LAS float* scr = (LAS float*)(lds + LDS_WORK + wave * 16384);
    constexpr int N_ITEMS = 3 * 8 * 32 + 16 * 32 + 2 * 32 * 8 + 2 * 4 * 2;
    for (int it0 = li * NWAVES + wave; it0 < N_ITEMS; it0 += NL * NWAVES) {
        int it = it0;
        if (tr_job(it, A.in[I_WBRN], 1024, 512, 0, 1024, (bf16*)(ws + WS_WBRT), 0, scr, lane)) continue;
        if (tr_job(it, A.in[I_WBRS], 1024, 512, 0, 1024, (bf16*)(ws + WS_WBRT) + 1024 * 512, 0, scr, lane)) continue;
        if (tr_job(it, A.in[I_WBRM], 1024, 512, 0, 1024, (bf16*)(ws + WS_WBRT) + 2 * 1024 * 512, 0, scr, lane)) continue;
        if (tr_job(it, A.in[I_WO], 1024, 1024, 0, 1024, (bf16*)(ws + WS_WOT), 0, scr, lane)) continue;
        if (tr_job<true>(it, A.in[I_W1K], 256, 2048, 0, 256, (bf16*)(ws + WS_W1T), 0, scr, lane)) continue;
        if (tr_job<true>(it, A.in[I_W1V], 256, 2048, 0, 256, (bf16*)(ws + WS_W1T) + 256 * 2048, 0, scr, lane)) continue;
        if (tr_job(it, A.in[I_W2K], 64, 256, 0, 64, (bf16*)(ws + WS_W2T), 0, scr, lane)) continue;
        tr_job(it, A.in[I_W2V], 64, 256, 0, 64, (bf16*)(ws + WS_W2T) + 64 * 256, 0, scr, lane);
    }
    __syncthreads();
}
constexpr int CV_PER_E = 2 * 16 * 8 + 4 * 32, CV_ITEMS = NEXP * CV_PER_E;
__device__ __forceinline__ void convert_range(const Args& A, LAS unsigned char* lds, int it_lo, int it_hi, int slot, int nslots, int wv) {
    const int tid = opaque_tid(wv), lane = tid & 63, wave = tid >> 6;
    LAS float* scr = (LAS float*)(lds + LDS_WORK + wave * 16384);
    bf16* WGUT = (bf16*)(A.ws + WS_WGUT); bf16* WDT = (bf16*)(A.ws + WS_WDT);
    constexpr int PER_E = CV_PER_E;
    for (int it0 = it_lo + slot; it0 < it_hi; it0 += nslots) {
        const int e = it0 / PER_E; int it = it0 % PER_E;
        if (it < 256) { const bool up = it >= 128; it &= 127; const int kb = it >> 3, cb = it & 7, f0 = 32 * cb;
            tr_item(A.in[up ? I_WEU : I_WEG] + (size_t)e * 1024 * 256, 256, 64 * kb, f0, 32, WGUT, 1024, e * 512 + (f0 >> 7) * 256 + (up ? 128 : 0) + (f0 & 127), scr, lane);
        } else { it -= 256; const int kb = it >> 5, cb = it & 31;
            tr_item(A.in[I_WED] + (size_t)e * 256 * 1024, 1024, 64 * kb, 32 * cb, 32, WDT, 256, e * 1024 + 32 * cb, scr, lane); }
    }
    __syncthreads();
}
constexpr int CW_CMP = 24576;
__device__ __forceinline__ void compress_unit(const Args& A, LAS unsigned char* lds, int unit, int wv) {
    const int tid = opaque_tid(wv), lane = tid & 63, wave = __builtin_amdgcn_readfirstlane(tid >> 6), c = lane & 15, q4 = lane >> 4;
    const int kv = unit >> 6, g = (unit >> 5) & 1, rb = unit & 31;
    const bf16* KV = (const bf16*)(A.ws + WS_KV); const float* pe = A.in[kv ? I_PEV : I_PEK];
    const bf16* W1T = (const bf16*)(A.ws + WS_W1T) + (size_t)kv * 256 * 2048; const bf16* W2T = (const bf16*)(A.ws + WS_W2T) + kv * 64 * 256;
    bf16* OUT = (bf16*)(A.ws + (kv ? WS_VCMP : WS_KCMP));
    const int coloff = kv * 128 + g * 64;
    constexpr int AP = 2048 + 8;
    LAS bf16* Aimg = (LAS bf16*)(lds + LDS_WORK); LAS bf16* hid = Aimg + 32 * AP;
    { const int bA = (rb * 32) >> 7, n0 = (rb * 32) & 127;
#pragma unroll 8
      for (int i = 0; i < 16; ++i) { const int id = tid + NTHR * i;
          const int r = id >> 8, l = (id >> 3) & 31, ch = id & 7; int tok = (n0 + r) * 16 + l; tok = tok < SEQ ? tok : SEQ - 1;
          const u32x4 kraw = *(const u32x4*)(KV + (size_t)(bA * SEQ + tok) * 768 + coloff + ch * 8);
          const f32x4 pe0 = *(const f32x4*)(pe + l * 64 + ch * 8), pe1 = *(const f32x4*)(pe + l * 64 + ch * 8 + 4);
          u32x4 o; o.x = pg8::cvt_pk_bf16(bflo(kraw.x) + pe0[0], bfhi(kraw.x) + pe0[1]); o.y = pg8::cvt_pk_bf16(bflo(kraw.y) + pe0[2], bfhi(kraw.y) + pe0[3]);
          o.z = pg8::cvt_pk_bf16(bflo(kraw.z) + pe1[0], bfhi(kraw.z) + pe1[1]); o.w = pg8::cvt_pk_bf16(bflo(kraw.w) + pe1[2], bfhi(kraw.w) + pe1[3]);
          *(LAS u32x4*)(Aimg + r * AP + l * 64 + ch * 8) = o; } }
    __syncthreads();
    f32x4 acc[2][2] = {{{0.f, 0.f, 0.f, 0.f}, {0.f, 0.f, 0.f, 0.f}}, {{0.f, 0.f, 0.f, 0.f}, {0.f, 0.f, 0.f, 0.f}}};
    const bf16* wf0 = W1T + ((size_t)(2 * wave) * 64 * 64 + lane) * 8; const bf16* wf1 = wf0 + (size_t)64 * 64 * 8;
    const int rot = (unit * 5) & 15;
    bf16x8 B0[4][2], B1[4][2], B2[4][2];
#define CMP_LOAD(B_, KB_) do { const int kq_ = (((KB_) + rot) & 15) * 4; _Pragma("unroll") for (int j = 0; j < 4; ++j) { B_[j][0] = *(const bf16x8*)(wf0 + (size_t)(kq_ + j) * 512); B_[j][1] = *(const bf16x8*)(wf1 + (size_t)(kq_ + j) * 512); } } while (0)
#define CMP_MMA(B_, KB_) do { const int kq_ = (((KB_) + rot) & 15) * 4; _Pragma("unroll") for (int j = 0; j < 4; ++j) { const int ks = kq_ + j; \
        const bf16x8 a0 = *(const LAS bf16x8*)(Aimg + c * AP + 32 * ks + 8 * q4), a1 = *(const LAS bf16x8*)(Aimg + (16 + c) * AP + 32 * ks + 8 * q4); \
        _Pragma("unroll") for (int nb = 0; nb < 2; ++nb) { acc[0][nb] = __builtin_amdgcn_mfma_f32_16x16x32_bf16(a0, B_[j][nb], acc[0][nb], 0, 0, 0); acc[1][nb] = __builtin_amdgcn_mfma_f32_16x16x32_bf16(a1, B_[j][nb], acc[1][nb], 0, 0, 0); } } } while (0)
    CMP_LOAD(B0, 0); CMP_LOAD(B1, 1);
#pragma unroll 1
    for (int i = 0; i < 5; ++i) {
        CMP_LOAD(B2, 3 * i + 2); CMP_MMA(B0, 3 * i);
        CMP_LOAD(B0, 3 * i + 3); CMP_MMA(B1, 3 * i + 1);
        if (i < 4) CMP_LOAD(B1, 3 * i + 4);
        CMP_MMA(B2, 3 * i + 2);
    }
    CMP_MMA(B0, 15);
#undef CMP_LOAD
#undef CMP_MMA
#pragma unroll
    for (int mt = 0; mt < 2; ++mt)
#pragma unroll
        for (int nb = 0; nb < 2; ++nb)
#pragma unroll
            for (int r = 0; r < 4; ++r) { const float x = acc[mt][nb][r]; const pg8::f32x2 gg = pg8::gelu_pk((pg8::f32x2){x, x}); hid[(16 * mt + 4 * q4 + r) * 264 + 32 * wave + 16 * nb + c] = (bf16)f2bf(gg.x); }
    __syncthreads();
    { const int mt = wave >> 2, nt = wave & 3;
      f32x4 o = {0.f, 0.f, 0.f, 0.f};
#pragma unroll
      for (int ks = 0; ks < 8; ++ks) { const bf16x8 a = *(const LAS bf16x8*)(hid + (16 * mt + c) * 264 + 32 * ks + 8 * q4); const bf16x8 b = *(const bf16x8*)(W2T + (16 * nt + c) * 256 + 32 * ks + 8 * q4);
          o = __builtin_amdgcn_mfma_f32_16x16x32_bf16(a, b, o, 0, 0, 0); }
#pragma unroll
      for (int r = 0; r < 4; ++r) { const int row = rb * 32 + 16 * mt + 4 * q4 + r, n = row & 127; const unsigned val = n == 127 ? 0u : f2bf(o[r]); bf16* op = OUT + ((size_t)row * 2 + g) * 64 + 16 * nt + c;
          asm volatile("global_store_short %0, %1, off sc1\n\ts_nop 1" :: "v"(op), "v"(val) : "memory"); } }
    asm volatile("s_waitcnt vmcnt(0)" ::: "memory");
    if (lane == 0) __hip_atomic_fetch_add((unsigned*)(A.ws + WS_CTL) + CW_CMP + 64 * ((rb >> 2) * 2 + g), 1u, RLX_AGENT);
    __syncthreads();
}
__device__ __forceinline__ void cmp_wait(const Args& A, int b, int g, int wv) {
    if (wv == 0) { unsigned* cnt = (unsigned*)(A.ws + WS_CTL) + CW_CMP + 64 * (b * 2 + g); unsigned polls = 0;
        while ((unsigned)__builtin_amdgcn_readfirstlane(__hip_atomic_load(cnt, RLX_AGENT)) < 64u) {
            if (++polls > (1u << 22)) { if (lane_id() == 0) __hip_atomic_store((unsigned*)(A.ws + WS_CTL) + CW_BAR + XB_TMO, 1u, RLX_AGENT); break; }
            __builtin_amdgcn_s_sleep(2); }
        __builtin_amdgcn_fence(__ATOMIC_ACQUIRE, "agent");
        asm volatile("s_waitcnt vmcnt(0)" ::: "memory"); }
    __syncthreads();
}

__device__ __forceinline__ void sgu_unit(const Args& A, LAS unsigned char* lds, int unit, int wv) {
    const int tid = opaque_tid(wv), lane = tid & 63, wave = __builtin_amdgcn_readfirstlane(tid >> 6), c = lane & 15, q4 = lane >> 4;
    const int half = unit & 1, bc = unit >> 1; const size_t row0 = (size_t)bc * 128;
    const bf16* Z = (const bf16*)(A.ws + WS_Z); bf16* OS = (bf16*)((unsigned char*)A.out + DO_OSGU);
    constexpr int VP = (256 + 16) * 2;
    LAS char* Vr = (LAS char*)(lds + LDS_WORK);
    { u32x4 w[16];
#pragma unroll
      for (int i = 0; i < 16; ++i) w[i] = *(const u32x4*)(Z + (row0 + wave * 16 + i) * 1024 + 512 + lane * 8);
      const float* lg = A.in[I_SLNG] + lane * 8; const float* lb = A.in[I_SLNB] + lane * 8;
      const f32x4 g0 = *(const f32x4*)lg, g1 = *(const f32x4*)(lg + 4), b0 = *(const f32x4*)lb, b1 = *(const f32x4*)(lb + 4);
      const float gg[8] = {g0[0], g0[1], g0[2], g0[3], g1[0], g1[1], g1[2], g1[3]}, bb[8] = {b0[0], b0[1], b0[2], b0[3], b1[0], b1[1], b1[2], b1[3]};
#pragma unroll
      for (int i = 0; i < 16; ++i) {
        float x[8] = {bflo(w[i].x), bfhi(w[i].x), bflo(w[i].y), bfhi(w[i].y), bflo(w[i].z), bfhi(w[i].z), bflo(w[i].w), bfhi(w[i].w)};
        float s = 0.f;
#pragma unroll
        for (int j = 0; j < 8; ++j) s += x[j];
        const float mean = wave_sum(s) * (1.f / 512.f); float q = 0.f;
#pragma unroll
        for (int j = 0; j < 8; ++j) { x[j] -= mean; q += x[j] * x[j]; }
        const float rstd = 1.0f / sqrtf(wave_sum(q) * (1.f / 512.f) + LN_EPS);
        if ((lane >> 5) == half) { u32x4 o;
            o.x = pk2(x[0] * rstd * gg[0] + bb[0], x[1] * rstd * gg[1] + bb[1]); o.y = pk2(x[2] * rstd * gg[2] + bb[2], x[3] * rstd * gg[3] + bb[3]);
            o.z = pk2(x[4] * rstd * gg[4] + bb[4], x[5] * rstd * gg[5] + bb[5]); o.w = pk2(x[6] * rstd * gg[6] + bb[6], x[7] * rstd * gg[7] + bb[7]);
            *(LAS u32x4*)(Vr + (wave * 16 + i) * VP + (lane & 31) * 16) = o; } } }
    const int t = 16 * wave + c; const int nks = (16 * wave + 15) / 32 + 1;
    const bf16* WS = (const bf16*)(A.ws + WS_SGUW);
    bf16x8 wsf[4][4];
#pragma unroll
    for (int gl = 0; gl < 4; ++gl)
#pragma unroll
        for (int ks = 0; ks < 4; ++ks) { const bf16* wp = WS + ((size_t)(4 * half + gl) * 128 + t) * 128 + 32 * ks + 4 * q4;
            union { bf16x8 v; u32x2 h[2]; } f; f.h[0] = (u32x2){0u, 0u}; f.h[1] = (u32x2){0u, 0u};
            if (ks < nks) { f.h[0] = *(const u32x2*)wp; f.h[1] = *(const u32x2*)(wp + 16); }
            wsf[gl][ks] = f.v; }
    u32x2 uu[4][4]; float bsv[4];
#pragma unroll
    for (int gl = 0; gl < 4; ++gl) { bsv[gl] = A.in[I_SBS][(4 * half + gl) * 128 + t];
#pragma unroll
        for (int mb = 0; mb < 4; ++mb) uu[gl][mb] = *(const u32x2*)(Z + (row0 + t) * 1024 + 64 * (4 * half + gl) + 16 * mb + 4 * q4); }
    __syncthreads();
#pragma unroll
    for (int gl = 0; gl < 4; ++gl) { const int g = 4 * half + gl;
        f32x4 acc[4] = {{0.f, 0.f, 0.f, 0.f}, {0.f, 0.f, 0.f, 0.f}, {0.f, 0.f, 0.f, 0.f}, {0.f, 0.f, 0.f, 0.f}};
#pragma unroll
        for (int ks = 0; ks < 4; ++ks) if (ks < nks) {
#pragma unroll
            for (int mb = 0; mb < 4; ++mb) { const LAS char* vp = Vr + (32 * ks + 4 * q4 + (c >> 2)) * VP + (64 * gl + 16 * mb + 4 * (c & 3)) * 2;
                const s16x4 lo = tr16(vp), hi = tr16(vp + 16 * VP);
                acc[mb] = __builtin_amdgcn_mfma_f32_16x16x32_bf16((bf16x8){lo[0], lo[1], lo[2], lo[3], hi[0], hi[1], hi[2], hi[3]}, wsf[gl][ks], acc[mb], 0, 0, 0); } }
        const float bs = bsv[gl];
        unsigned olo[4], ohi[4];
#pragma unroll
        for (int mb = 0; mb < 4; ++mb) { const u32x2 u2 = uu[gl][mb];
            olo[mb] = pk2(bflo(u2.x) * (acc[mb][0] + bs), bfhi(u2.x) * (acc[mb][1] + bs)); ohi[mb] = pk2(bflo(u2.y) * (acc[mb][2] + bs), bfhi(u2.y) * (acc[mb][3] + bs)); }
        store_row64_wt(OS + (row0 + t) * 512 + 64 * g, olo, ohi, q4);
    }
    wave_signal((unsigned*)(A.ws + WS_CTL) + CW_P4 + 16 * (bc >> 1));
    __syncthreads();
}

struct MaskNone { __device__ __forceinline__ bool valid(int) const { return true; } __device__ __forceinline__ bool skip(int) const { return false; } __device__ __forceinline__ int mode(int) const { return 0; } __device__ __forceinline__ bool lanepred(int) const { return true; } };
__device__ __forceinline__ void mem_unit(const Args& A, LAS unsigned char* lds, int unit, int wv) {
    const int tid = opaque_tid(wv), lane = tid & 63, wave = __builtin_amdgcn_readfirstlane(tid >> 6), c = lane & 15, q4 = lane >> 4;
    const int qt = unit & 7, h = (unit >> 3) & 3, b = unit >> 5;
    bf16* MQ = (bf16*)(A.ws + WS_MQ); const bf16* KVM = (const bf16*)(A.ws + WS_KVMEM) + (size_t)b * 256 * 1024 + h * 128;
    f32x4 acc[2][8]; float mrun[2], lrun[2];
    const size_t t0 = (size_t)b * SEQ + qt * 256 + wave * 32;
    bf16x8 qf[2][4];
#pragma unroll
    for (int cg = 0; cg < 2; ++cg)
#pragma unroll
        for (int ks = 0; ks < 4; ++ks) qf[cg][ks] = *(const bf16x8*)(MQ + (t0 + 16 * cg + c) * 512 + h * 128 + 32 * ks + 8 * q4);
#pragma unroll
    for (int cg = 0; cg < 2; ++cg) { mrun[cg] = M_INIT; lrun[cg] = 0.f;
#pragma unroll
        for (int db = 0; db < 8; ++db) acc[cg][db] = (f32x4){0.f, 0.f, 0.f, 0.f}; }
    MaskNone mf;
    attn_all<128, 2, 4, MaskNone>((LAS char*)(lds + LDS_WORK), KVM, KVM + 512, 1024, mf, qf, acc, mrun, lrun, tid, lane);
#pragma unroll
    for (int cg = 0; cg < 2; ++cg) { float l = xrow16_sum(lrun[cg]); const float inv = l > 0.f ? 1.0f / l : 0.f;
#pragma unroll
        for (int dh = 0; dh < 2; ++dh) { unsigned olo[4], ohi[4];
#pragma unroll
            for (int j = 0; j < 4; ++j) { const int db = 4 * dh + j; olo[j] = pk2(acc[cg][db][0] * inv, acc[cg][db][1] * inv); ohi[j] = pk2(acc[cg][db][2] * inv, acc[cg][db][3] * inv); }
            store_row64_wt(MQ + (t0 + 16 * cg + c) * 512 + h * 128 + 64 * dh, olo, ohi, q4); } }
    wave_signal((unsigned*)(A.ws + WS_CTL) + CW_P4 + 16 * (b * 8 + qt));
}
struct MaskSel { int qpos, q0, q64; unsigned sel;
    __device__ __forceinline__ bool valid(int k) const { return k <= qpos; }
    __device__ __forceinline__ bool skip(int t) const { return 64 * t > q0 + 15; }
    __device__ __forceinline__ int mode(int t) const { return t < q64 ? 1 : 2; }
    __device__ __forceinline__ bool lanepred(int t) const { return (sel >> t) & 1u; } };
struct MaskWin { int qpos, q0;
    __device__ __forceinline__ bool valid(int k) const { return k <= qpos && k > qpos - 512; }
    __device__ __forceinline__ bool skip(int t) const { return 64 * t > q0 + 15 || 64 * t + 63 < q0 - 511; }
    __device__ __forceinline__ int mode(int t) const { return (64 * t + 63 <= q0 && 64 * t >= q0 + 15 - 511) ? 0 : 2; }
    __device__ __forceinline__ bool lanepred(int) const { return true; } };
__device__ __forceinline__ void nsa_unit(const Args& A, LAS unsigned char* lds, int b, int g, int q64, int wv) {
    const int tid = opaque_tid(wv), lane = tid & 63, wave = __builtin_amdgcn_readfirstlane(tid >> 6); int c = lane & 15, q4 = lane >> 4;
    asm volatile("" : "+v"(c), "+v"(q4));
    const int qg = wave & 3, hp = wave >> 2;
    const int q0 = q64 * 64 + qg * 16, qpos = q0 + c; const size_t trow = (size_t)b * SEQ + qpos;
    const bf16* Qp = (const bf16*)(A.ws + WS_Q) + trow * 512 + g * 256 + hp * 128;
    const bf16* KV = (const bf16*)(A.ws + WS_KV) + (size_t)b * SEQ * 768 + g * 64;
    const float* NG = (const float*)(A.ws + WS_NG) + trow * 32 + g * 12 + hp * 6;
    LAS char* buf = (LAS char*)(lds + LDS_WORK);
    constexpr int TB = ATile<64>::BYTES, PT = ATile<64>::PITCH;
    LAS char* cbuf = buf + 4 * TB;
    LAS float* impx = (LAS float*)(buf + 8 * TB);
    bf16x8 qf[2][2];
#pragma unroll
    for (int cg = 0; cg < 2; ++cg)
#pragma unroll
        for (int ks = 0; ks < 2; ++ks) qf[cg][ks] = *(const bf16x8*)(Qp + cg * 64 + 32 * ks + 8 * q4);
    float gate[2][3];
#pragma unroll
    for (int cg = 0; cg < 2; ++cg)
#pragma unroll
        for (int br = 0; br < 3; ++br) gate[cg][br] = NG[cg * 3 + br];
    f32x4 osum[2][4];
    { const bf16* KC = (const bf16*)(A.ws + WS_KCMP) + ((size_t)b * 128 * 2 + g) * 64; const bf16* VC = (const bf16*)(A.ws + WS_VCMP) + ((size_t)b * 128 * 2 + g) * 64;
      u32x4 r0[1], r1[1], r2[1], r3[1];
      tile_load<64>(KC, 128, tid, r0); tile_load<64>(VC, 128, tid, r1); tile_load<64>(KC + 64 * 128, 128, tid, r2); tile_load<64>(VC + 64 * 128, 128, tid, r3);
      tile_store<64>(cbuf, tid, r0); tile_store<64>(cbuf + TB, tid, r1); tile_store<64>(cbuf + 2 * TB, tid, r2); tile_store<64>(cbuf + 3 * TB, tid, r3); }
    const int tlo = q64 - 8 > 0 ? q64 - 8 : 0;
    const NsaStream<64> strm{KV + 256, KV + 384, KV + 512, KV + 640, 768, q64 + 1, tlo, (q64 + 1) + (q64 - tlo + 1)};
    u32x4 ka[2][1], va[2][1];
    { u32x4 kf[2][1], vf[2][1]; strm.load<2>(0, kf, vf, tid); strm.load<2>(2, ka, va, tid); strm.store<2>(0, buf, kf, vf, tid); }
    __syncthreads();
    float imp[8];
#pragma unroll
    for (int i = 0; i < 8; ++i) imp[i] = 0.f;
#pragma unroll
    for (int cg = 0; cg < 2; ++cg) {
        asm volatile("" ::: "memory");
        f32x4 st[8];
#pragma unroll
        for (int sh = 0; sh < 8; ++sh) { const LAS char* Kt = cbuf + (sh >> 2) * 2 * TB; f32x4 s = {0.f, 0.f, 0.f, 0.f};
#pragma unroll
            for (int ks = 0; ks < 2; ++ks) { const bf16x8 kf = *(const LAS bf16x8*)(Kt + (16 * (sh & 3) + c) * PT + (32 * ks + 8 * q4) * 2);
                s = __builtin_amdgcn_mfma_f32_16x16x32_bf16(kf, qf[cg][ks], s, 0, 0, 0); }
            st[sh] = s; }
        float mx = -1e30f;
#pragma unroll
        for (int sh = 0; sh < 8; ++sh)
#pragma unroll
            for (int r = 0; r < 4; ++r) { const int n = 16 * sh + 4 * q4 + r; const bool ok = 16 * n + 31 <= qpos; st[sh][r] = ok ? st[sh][r] : -__builtin_inff(); mx = fmaxf(mx, st[sh][r]); }
        mx = xrow16_max(mx);
        float sum = 0.f;
#pragma unroll
        for (int sh = 0; sh < 8; ++sh)
#pragma unroll
            for (int r = 0; r < 4; ++r) { const float e = fast_exp2(st[sh][r] - mx); st[sh][r] = e; sum += e; }
        sum = xrow16_sum(sum);
        const float inv = sum > 0.f ? 1.0f / sum : 0.f;
        float prev3 = 0.f;
#pragma unroll
        for (int sh = 0; sh < 8; ++sh) { st[sh] = st[sh] * inv;
            const float send = q4 == 3 ? prev3 : st[sh][3];
            const float got = __shfl(send, (lane + 48) & 63);
            imp[sh] += (st[sh][0] + st[sh][1]) + (st[sh][2] + st[sh][3]) + got;
            prev3 = st[sh][3]; }
        f32x4 acc[4] = {{0.f, 0.f, 0.f, 0.f}, {0.f, 0.f, 0.f, 0.f}, {0.f, 0.f, 0.f, 0.f}, {0.f, 0.f, 0.f, 0.f}};
#pragma unroll
        for (int s4 = 0; s4 < 4; ++s4) { const LAS char* Vt = cbuf + (s4 >> 1) * 2 * TB + TB;
            union { bf16x8 v; unsigned u[4]; } pf;
            pf.u[0] = pg8::cvt_pk_bf16(st[2 * s4][0], st[2 * s4][1]); pf.u[1] = pg8::cvt_pk_bf16(st[2 * s4][2], st[2 * s4][3]); pf.u[2] = pg8::cvt_pk_bf16(st[2 * s4 + 1][0], st[2 * s4 + 1][1]); pf.u[3] = pg8::cvt_pk_bf16(st[2 * s4 + 1][2], st[2 * s4 + 1][3]);
#pragma unroll
            for (int db = 0; db < 4; ++db) { const LAS char* vp = Vt + (32 * (s4 & 1) + 4 * q4 + (c >> 2)) * PT + (16 * db + 4 * (c & 3)) * 2;
                const s16x4 lo = tr16(vp), hi = tr16(vp + 16 * PT);
                acc[db] = __builtin_amdgcn_mfma_f32_16x16x32_bf16((bf16x8){lo[0], lo[1], lo[2], lo[3], hi[0], hi[1], hi[2], hi[3]}, pf.v, acc[db], 0, 0, 0); } }
#pragma unroll
        for (int db = 0; db < 4; ++db) osum[cg][db] = acc[db] * gate[cg][0];
    }
#pragma unroll
    for (int sh = 0; sh < 8; sh += 4) *(LAS f32x4*)(impx + (wave * 64 + lane) * 8 + sh) = (f32x4){imp[sh], imp[sh + 1], imp[sh + 2], imp[sh + 3]};
    __syncthreads();
#pragma unroll
    for (int sh = 0; sh < 8; sh += 4) { const f32x4 o = *(const LAS f32x4*)(impx + ((wave ^ 4) * 64 + lane) * 8 + sh); imp[sh] += o[0]; imp[sh + 1] += o[1]; imp[sh + 2] += o[2]; imp[sh + 3] += o[3]; }
    unsigned sel = 0u;
    { const int cur = qpos >> 6; unsigned key[8];
#pragma unroll
        for (int sh = 0; sh < 8; ++sh) { const int j = 4 * sh + q4; const unsigned tie = 31u - (unsigned)j;
            const bool fut = j > cur, forced = (j == 0) || (j == cur) || (j == cur - 1);
            key[sh] = fut ? tie : forced ? (0x7F000000u | tie) : ((__builtin_bit_cast(unsigned, imp[sh]) & ~31u) | tie) + 64u; }
#pragma unroll 1
        for (int it = 0; it < 8; ++it) { unsigned mxk = 0u;
#pragma unroll
            for (int sh = 0; sh < 8; ++sh) mxk = key[sh] > mxk ? key[sh] : mxk;
            mxk = xrow16_umax(mxk);
#pragma unroll
            for (int sh = 0; sh < 8; ++sh) if (key[sh] == mxk) { sel |= 1u << (4 * sh + q4); key[sh] = 0u; } }
        sel = xrow16_or(sel); }
    { f32x4 acc[2][4]; float mrun[2], lrun[2];
#pragma unroll
      for (int cg = 0; cg < 2; ++cg) { mrun[cg] = M_INIT; lrun[cg] = 0.f;
#pragma unroll
          for (int db = 0; db < 4; ++db) acc[cg][db] = (f32x4){0.f, 0.f, 0.f, 0.f}; }
      auto fin = [&](f32x4 (&ac)[2][4], float (&mr)[2], float (&lr)[2]) __attribute__((always_inline)) {
#pragma unroll
          for (int cg = 0; cg < 2; ++cg) { const float l = xrow16_sum(lr[cg]); const float sc = (l > 0.f ? 1.0f / l : 0.f) * gate[cg][1];
#pragma unroll
              for (int db = 0; db < 4; ++db) { osum[cg][db] += ac[cg][db] * sc; ac[cg][db] = (f32x4){0.f, 0.f, 0.f, 0.f}; }
              mr[cg] = M_INIT; lr[cg] = 0.f; } };
      attn_loop2<64, 2, 2>(buf, strm, qpos, q0, q64, sel, qf, acc, mrun, lrun, fin, ka, va, tid, lane);
      bf16* ON = (bf16*)((unsigned char*)A.out + DO_ONSA) + trow * 512 + g * 256 + hp * 128;
#pragma unroll
      for (int cg = 0; cg < 2; ++cg) { float l = xrow16_sum(lrun[cg]); const float sc = (l > 0.f ? 1.0f / l : 0.f) * gate[cg][2];
          unsigned olo[4], ohi[4];
#pragma unroll
          for (int db = 0; db < 4; ++db) { const f32x4 v = osum[cg][db] + acc[cg][db] * sc; olo[db] = pk2(v[0], v[1]); ohi[db] = pk2(v[2], v[3]); }
          store_row64_wt(ON + cg * 64, olo, ohi, q4); } }
    wave_signal((unsigned*)(A.ws + WS_CTL) + CW_P4 + 16 * (b * 8 + (q64 >> 2)));
}
__device__ __forceinline__ void p5_ln_router(const Args& A, LAS unsigned char* lds, int vcu, int G, int wv) {
    const int tid = opaque_tid(wv), lane = tid & 63, wave = __builtin_amdgcn_readfirstlane(tid >> 6), c_ = lane & 15, q4_ = lane >> 4, rt = wave & 3, kh = wave >> 2;
    float* X1 = A.out; bf16* X1B = (bf16*)(A.ws + WS_X1BF); int* TOK = (int*)(A.ws + WS_TOK); unsigned* cnt = (unsigned*)(A.ws + WS_CTL) + CW_CNT;
    const float* lg = A.in[I_LN1G]; const float* lb = A.in[I_LN1B];
    const bf16* WRH = (const bf16*)(A.ws + WS_WRH); const bf16* WRL = (const bf16*)(A.ws + WS_WRL);
    LAS float* xst = (LAS float*)(lds + LDS_WORK);
    LAS f32x4* xacc = (LAS f32x4*)(lds + LDS_WORK + 1024);
    LAS float* lgt = (LAS float*)(lds + LDS_WORK + 1024 + 12288);
    LAS unsigned* lcnt = (LAS unsigned*)(lds + LDS_MISC) + 160;
    for (int blk = vcu; blk < T / 64; blk += G) {
        int c = c_, q4 = q4_; asm volatile("" : "+v"(c), "+v"(q4));
        const int row = blk * 64 + rt * 16 + c; const int k00 = kh * 512 + 8 * q4; const size_t rbase = (size_t)row * 1024 + k00;
        f32x4 v[16][2];
#pragma unroll
        for (int ks = 0; ks < 16; ++ks) { v[ks][0] = __builtin_nontemporal_load((const f32x4*)(X1 + rbase + 32 * ks)); v[ks][1] = __builtin_nontemporal_load((const f32x4*)(X1 + rbase + 32 * ks + 4)); }
        if (tid < 32) lcnt[tid] = 0u;
        float s = 0.f;
#pragma unroll
        for (int ks = 0; ks < 16; ++ks) s += ((v[ks][0][0] + v[ks][0][1]) + (v[ks][0][2] + v[ks][0][3])) + ((v[ks][1][0] + v[ks][1][1]) + (v[ks][1][2] + v[ks][1][3]));
        s = xrow16_sum(s);
        if (q4 == 0) xst[wave * 16 + c] = s;
        __syncthreads();
        const float mean = (xst[rt * 16 + c] + xst[(rt + 4) * 16 + c]) * (1.f / 1024.f);
        float q = 0.f;
#pragma unroll
        for (int ks = 0; ks < 16; ++ks) { v[ks][0] = v[ks][0] - mean; v[ks][1] = v[ks][1] - mean;
            q += ((v[ks][0][0] * v[ks][0][0] + v[ks][0][1] * v[ks][0][1]) + (v[ks][0][2] * v[ks][0][2] + v[ks][0][3] * v[ks][0][3])) + ((v[ks][1][0] * v[ks][1][0] + v[ks][1][1] * v[ks][1][1]) + (v[ks][1][2] * v[ks][1][2] + v[ks][1][3] * v[ks][1][3])); }
        q = xrow16_sum(q);
        __syncthreads();
        if (q4 == 0) xst[wave * 16 + c] = q;
        __syncthreads();
        const float rstd = 1.0f / sqrtf((xst[rt * 16 + c] + xst[(rt + 4) * 16 + c]) * (1.f / 1024.f) + LN_EPS);
        f32x4 acc[3] = {{0.f, 0.f, 0.f, 0.f}, {0.f, 0.f, 0.f, 0.f}, {0.f, 0.f, 0.f, 0.f}};
        const bf16* wh0 = WRH + (size_t)c * 1024 + k00; const bf16* wl0 = WRL + (size_t)c * 1024 + k00;
#pragma unroll
        for (int ks = 0; ks < 16; ++ks) {
            const f32x4 g0 = *(const f32x4*)(lg + k00 + 32 * ks), g1 = *(const f32x4*)(lg + k00 + 32 * ks + 4), b0 = *(const f32x4*)(lb + k00 + 32 * ks), b1 = *(const f32x4*)(lb + k00 + 32 * ks + 4);
            const f32x4 x0 = v[ks][0] * rstd * g0 + b0, x1 = v[ks][1] * rstd * g1 + b1;
            union { bf16x8 v; unsigned u[4]; } xh, xl;
            xh.u[0] = pk2(x0[0], x0[1]); xh.u[1] = pk2(x0[2], x0[3]); xh.u[2] = pk2(x1[0], x1[1]); xh.u[3] = pk2(x1[2], x1[3]);
            if (!A.pad) *(u32x4*)(X1B + rbase + 32 * ks) = (u32x4){xh.u[0], xh.u[1], xh.u[2], xh.u[3]};
            xl.u[0] = pk2(x0[0] - bflo(xh.u[0]), x0[1] - bfhi(xh.u[0])); xl.u[1] = pk2(x0[2] - bflo(xh.u[1]), x0[3] - bfhi(xh.u[1]));
            xl.u[2] = pk2(x1[0] - bflo(xh.u[2]), x1[1] - bfhi(xh.u[2])); xl.u[3] = pk2(x1[2] - bflo(xh.u[3]), x1[3] - bfhi(xh.u[3]));
#pragma unroll
            for (int nt = 0; nt < 3; ++nt) { const bf16x8 wh = *(const bf16x8*)(wh0 + nt * 16 * 1024 + 32 * ks), wl = *(const bf16x8*)(wl0 + nt * 16 * 1024 + 32 * ks);
                acc[nt] = __builtin_amdgcn_mfma_f32_16x16x32_bf16(xh.v, wh, acc[nt], 0, 0, 0);
                acc[nt] = __builtin_amdgcn_mfma_f32_16x16x32_bf16(xh.v, wl, acc[nt], 0, 0, 0);
                acc[nt] = __builtin_amdgcn_mfma_f32_16x16x32_bf16(xl.v, wh, acc[nt], 0, 0, 0); }
            if (ks & 1) asm volatile("" ::: "memory"); }
        if (kh) {
#pragma unroll
            for (int nt = 0; nt < 3; ++nt) xacc[(rt * 3 + nt) * 64 + lane] = acc[nt]; }
        __syncthreads();
        if (!kh) {
#pragma unroll
            for (int nt = 0; nt < 3; ++nt) { const f32x4 o1 = xacc[(rt * 3 + nt) * 64 + lane];
#pragma unroll
                for (int r = 0; r < 4; ++r) lgt[(rt * 16 + 4 * q4 + r) * 48 + 16 * nt + c] = acc[nt][r] + o1[r]; } }
        __syncthreads();
        int ex0 = 0, ex1 = 0; float w0 = 0.f, w1 = 0.f; unsigned r0 = 0u, r1 = 0u;
        if (tid < 64) {
            const LAS float* L = lgt + tid * 48; float gl[4];
#pragma unroll
            for (int o = 0; o < 4; ++o) gl[o] = L[o] + A.in[I_BRG][o];
            int gi = 0; float gm = gl[0];
#pragma unroll
            for (int o = 1; o < 4; ++o) if (gl[o] > gm) { gm = gl[o]; gi = o; }
            const float gprob = 1.0f / ((expf(gl[0] - gm) + expf(gl[1] - gm)) + (expf(gl[2] - gm) + expf(gl[3] - gm)));
            float el[8];
#pragma unroll
            for (int e = 0; e < 8; ++e) el[e] = L[4 + gi * 8 + e] + A.in[I_BRE][gi * 8 + e];
            int i0 = 0; float m0 = el[0];
#pragma unroll
            for (int e = 1; e < 8; ++e) if (el[e] > m0) { m0 = el[e]; i0 = e; }
            int i1 = -1; float m1 = -3.0e38f;
#pragma unroll
            for (int e = 0; e < 8; ++e) if (e != i0 && el[e] > m1) { m1 = el[e]; i1 = e; }
            const float e1 = expf(m1 - m0), den = 1.0f / (1.0f + e1);
            w0 = gprob * den; w1 = gprob * e1 * den; ex0 = gi * 8 + i0; ex1 = gi * 8 + i1;
            r0 = atomicAdd((unsigned*)(lcnt + ex0), 1u); r1 = atomicAdd((unsigned*)(lcnt + ex1), 1u);
        }
        __syncthreads();
        if (tid < 32) { const unsigned cc = lcnt[tid]; lcnt[32 + tid] = (cc && !A.pad) ? __hip_atomic_fetch_add(cnt + 64 * tid, cc, RLX_AGENT) : 0u; }
        __syncthreads();
        if (tid < 64 && !A.pad) { int* o = TOK + (size_t)(blk * 64 + tid) * 8;
            o[0] = ex0; o[1] = ex1; o[2] = __builtin_bit_cast(int, w0); o[3] = __builtin_bit_cast(int, w1); o[4] = (int)(r0 + lcnt[32 + ex0]); o[5] = (int)(r1 + lcnt[32 + ex1]); }
        __syncthreads();
    }
}
__device__ __forceinline__ void p6_route(const Args& A, LAS unsigned char* lds, int blk0, int G, int wv) {
    const int tid = opaque_tid(wv);
    int* TOK = (int*)(A.ws + WS_TOK); unsigned* cnt = (unsigned*)(A.ws + WS_CTL) + CW_CNT; const float* PLG = (const float*)(A.ws + WS_PLG);
    LAS float* lgt = (LAS float*)(lds + LDS_WORK);
    LAS unsigned* lcnt = (LAS unsigned*)(lds + LDS_MISC) + 160;
    for (int blk = blk0; blk < T / 64; blk += G) {
        if (tid < 32) lcnt[tid] = 0u;
        for (int idx = tid; idx < 64 * 36; idx += NTHR) { const int rr = idx / 36, e = idx - rr * 36; const float* p = PLG + (size_t)(blk * 64 + rr) * 144 + e;
            lgt[rr * 48 + e] = (p[0] + p[36]) + (p[72] + p[108]); }
        __syncthreads();
        int ex0 = 0, ex1 = 0; float w0 = 0.f, w1 = 0.f; unsigned r0 = 0u, r1 = 0u;
        if (tid < 64) {
            const LAS float* L = lgt + tid * 48; float gl[4];
#pragma unroll
            for (int o = 0; o < 4; ++o) gl[o] = L[o] + A.in[I_BRG][o];
            int gi = 0; float gm = gl[0];
#pragma unroll
            for (int o = 1; o < 4; ++o) if (gl[o] > gm) { gm = gl[o]; gi = o; }
            const float gprob = 1.0f / ((expf(gl[0] - gm) + expf(gl[1] - gm)) + (expf(gl[2] - gm) + expf(gl[3] - gm)));
            float el[8];
#pragma unroll
            for (int e = 0; e < 8; ++e) el[e] = L[4 + gi * 8 + e] + A.in[I_BRE][gi * 8 + e];
            int i0 = 0; float m0 = el[0];
#pragma unroll
            for (int e = 1; e < 8; ++e) if (el[e] > m0) { m0 = el[e]; i0 = e; }
            int i1 = -1; float m1 = -3.0e38f;
#pragma unroll
            for (int e = 0; e < 8; ++e) if (e != i0 && el[e] > m1) { m1 = el[e]; i1 = e; }
            const float e1 = expf(m1 - m0), den = 1.0f / (1.0f + e1);
            w0 = gprob * den; w1 = gprob * e1 * den; ex0 = gi * 8 + i0; ex1 = gi * 8 + i1;
            r0 = atomicAdd((unsigned*)(lcnt + ex0), 1u); r1 = atomicAdd((unsigned*)(lcnt + ex1), 1u);
        }
        __syncthreads();
        if (tid < 32) { const unsigned cc = lcnt[tid]; lcnt[32 + tid] = (cc && !A.pad) ? __hip_atomic_fetch_add(cnt + 64 * tid, cc, RLX_AGENT) : 0u; }
        __syncthreads();
        if (tid < 64) { int* LIST = (int*)((unsigned char*)A.out + DO_LIST); float* WLIST = (float*)((unsigned char*)A.out + DO_WLIST);
            const int tok = blk * 64 + tid; const size_t p0 = (size_t)ex0 * LIST_CAP + (r0 + lcnt[32 + ex0]), p1 = (size_t)ex1 * LIST_CAP + (r1 + lcnt[32 + ex1]);
            LIST[p0] = tok * 2; WLIST[p0] = w0; LIST[p1] = tok * 2 + 1; WLIST[p1] = w1; }
        __syncthreads();
    }
}
__device__ __forceinline__ void cnt_wait(const Args& A, unsigned* cnt, unsigned want, int wv) {
    if (wv == 0) { unsigned polls = 0;
        while ((unsigned)__builtin_amdgcn_readfirstlane(__hip_atomic_load(cnt, RLX_AGENT)) < want) {
            if (++polls > (1u << 22)) { if (lane_id() == 0) __hip_atomic_store((unsigned*)(A.ws + WS_CTL) + CW_BAR + XB_TMO, 1u, RLX_AGENT); break; }
            __builtin_amdgcn_s_sleep(2); }
        __builtin_amdgcn_fence(__ATOMIC_ACQUIRE, "agent");
        asm volatile("s_waitcnt vmcnt(0)" ::: "memory"); }
    __syncthreads();
}
__device__ __forceinline__ void expert_offsets(const unsigned* cnt, int lane, unsigned& mycnt, unsigned& myoff) {
    mycnt = lane < 32 ? __hip_atomic_load((unsigned*)cnt + 64 * lane, RLX_AGENT) : 0u;
    const unsigned pad = (mycnt + 255u) & ~255u; unsigned inc = pad;
#pragma unroll
    for (int o = 1; o < 32; o <<= 1) { const unsigned n = __shfl_up(inc, o); if (lane >= o) inc += n; }
    myoff = inc - pad;
}
__device__ __forceinline__ void p5b_scatter(const Args& A, int vcu, int G, int wv) {
    const int tid = opaque_tid(wv), lane = tid & 63, wave = __builtin_amdgcn_readfirstlane(tid >> 6);
    unsigned mycnt, myoff; expert_offsets((const unsigned*)(A.ws + WS_CTL) + CW_CNT, lane, mycnt, myoff);
    const int* TOK = (const int*)(A.ws + WS_TOK); int* TOKOF = (int*)(A.ws + WS_TOKOF); float* CWT = (float*)(A.ws + WS_CWT);
    for (int row = vcu * NTHR + tid; row < T; row += G * NTHR) {
        const int* tk = TOK + (size_t)row * 8;
#pragma unroll
        for (int k = 0; k < 2; ++k) { const int e = tk[k]; const unsigned pos = __shfl(myoff, e) + (unsigned)tk[4 + k]; TOKOF[pos] = row * 2 + k; CWT[pos] = __builtin_bit_cast(float, tk[2 + k]); }
    }
}
constexpr int CW_HCNT = 8192;
template <int KIND> struct MoeOrder {
    const volatile LAS unsigned* tb; unsigned* hcnt; unsigned* tmo; int wv;
    static constexpr int LB = KIND == 0 ? 120 : 130;
    __device__ __forceinline__ bool next(int i, pg8::Unit& u) const { if (i >= (int)tb[LB]) return false; u.pm = (int)tb[LB + 1 + 2 * i]; const unsigned v = tb[LB + 2 + 2 * i]; u.pn = (int)(v & 0xffffu); u.hm = KIND == 0 ? (int)(v >> 16) : i;        return true; }
    static constexpr bool GATHER = (KIND == 0), HALFM = (KIND == 0);
    const LAS unsigned* utab;
    __device__ __forceinline__ unsigned rowoff(const pg8::Unit& u, int r) const { const int i = (u.pm == (int)tb[121]) ? 0 : 1;
        return (utab[i * 256 + r] >> 1) * 2048u; }
    __device__ __forceinline__ void a_ready(const pg8::Unit&) const {}
    __device__ __forceinline__ void done(const pg8::Unit& u) const {
        if constexpr (KIND == 0) { asm volatile("s_waitcnt vmcnt(0)" ::: "memory");
            if (lane_id() == 0) __hip_atomic_fetch_add(hcnt + 64 * u.pm, u.hm ? 1u : 2u, RLX_AGENT); }
    }
    __device__ __forceinline__ const char* pa(const pg8::Gemm& g, const pg8::Unit& u, size_t tstep) const { return (const char*)g.A + (GATHER ? (size_t)0 : (size_t)u.pm * tstep); }
    __device__ __forceinline__ const char* pb(const pg8::Gemm& g, const pg8::Unit& u, size_t tstep) const { return (const char*)g.Bt + (size_t)u.pn * tstep; }
};
__device__ __forceinline__ void moe_wait_tiles(const volatile LAS unsigned* tb, unsigned* hcnt, unsigned* tmo, int wv) {
    if (wv == 0) { const int n = (int)tb[130], lane = lane_id();
        const int pm = lane < n ? (int)tb[131 + 2 * lane] : 0; unsigned polls = 0;
        for (;;) { const unsigned v = lane < n ? __hip_atomic_load(hcnt + 64 * pm, RLX_AGENT) : 32u;
            if (__builtin_amdgcn_ballot_w64(v < 32u) == 0ull) break;
            if (++polls > (1u << 22)) { if (lane == 0) __hip_atomic_store(tmo, 1u, RLX_AGENT); break; }
            __builtin_amdgcn_s_sleep(2); }
        __builtin_amdgcn_fence(__ATOMIC_ACQUIRE, "agent");
        asm volatile("s_waitcnt vmcnt(0)" ::: "memory"); }
    __syncthreads();
}
__device__ __forceinline__ void moe_tables(const Args& A, volatile LAS unsigned* tb, int tid, int G, int c) {
    if (tid < 64) { unsigned mycnt, myoff; expert_offsets((const unsigned*)(A.ws + WS_CTL) + CW_CNT, tid, mycnt, myoff);
        if (tid < 32) { tb[tid] = myoff >> 8; tb[40 + tid] = myoff >> 8; tb[80 + tid] = mycnt; }
        const int pre = tid < 32 ? (int)(myoff >> 8) : 0x7fffffff;
        const int tiles = __builtin_amdgcn_readlane((int)((myoff + ((mycnt + 255u) & ~255u)) >> 8), 31), NU = 2 * tiles;
        if (tid == 31) tb[32] = (unsigned)tiles;
        const int R = NU > G ? NU - G : 0, R2 = 2 * R, NL = G - R2, half = G / 2;
#pragma unroll
        for (int kind = 0; kind < 2; ++kind) { const int LB = kind ? 130 : 120; int n = 0; bool live = true;
#pragma unroll
            for (int k = 0; k < 4; ++k) { int tile = 0, j = 0, NJ = 2, hm = 0; bool ok = live;
                if (kind == 0) { if (k == 0) { ok = ok && c < NU; tile = c >> 1; j = c & 1; } else { ok = ok && k == 1 && c < R2; const int L = G + (c >> 1); tile = L >> 1; j = L & 1; hm = 1 + (c & 1); } NJ = 2; }
                else if (c >= R2) { const int D = (c - R2) + k * NL; const int lim = 4 * (tiles < half ? tiles : half); ok = ok && D < lim; tile = D >> 2; j = D & 3; NJ = 4; }
                else { const int D = c; const int lim = 4 * (tiles > half ? tiles - half : 0); ok = ok && k == 0 && D < lim; tile = half + (D >> 2); j = D & 3; NJ = 4; }
                live = ok;
                const int e = (int)__builtin_popcountll(__builtin_amdgcn_ballot_w64(pre <= tile)) - 1;
                if (ok && tid == 0) { tb[LB + 1 + 2 * n] = (unsigned)tile; tb[LB + 2 + 2 * n] = (unsigned)(e * NJ + j) | ((unsigned)hm << 16); }
                n += ok ? 1 : 0; }
            if (tid == 0) tb[LB] = (unsigned)n; } }
    __syncthreads();
}
struct EpiMoeUp {
    static constexpr bool PERM = true, AFTER_DRAIN = false;
    __device__ __forceinline__ bool keep(const pg8::Unit&) const { return false; }
    bf16* H;
    __device__ __forceinline__ void operator()(const f32x4 (&acc)[2][2][4][2], const pg8::Unit& u, int wr, int wc, int fr, int fq) const {
        const int row0 = u.pm * 256 + (u.hm == 2 ? 128 : 0) + wr * 64 + fr, col0 = (u.pn & 1) * 128 + wc * 32 + 8 * fq;
#pragma unroll
        for (int ai = 0; ai < 2; ++ai) { if (ai == 1 && u.hm != 0) break;
#pragma unroll
            for (int m = 0; m < 4; ++m) { float h[8];
#pragma unroll
                for (int n = 0; n < 2; ++n)
#pragma unroll
                    for (int i = 0; i < 4; ++i) { const float gt = acc[ai][0][m][n][i], up = acc[ai][1][m][n][i]; h[4 * n + i] = gt * sigmoidf_(gt) * up; }
                u32x4 w; w.x = pg8::cvt_pk_bf16(h[0], h[1]); w.y = pg8::cvt_pk_bf16(h[2], h[3]); w.z = pg8::cvt_pk_bf16(h[4], h[5]); w.w = pg8::cvt_pk_bf16(h[6], h[7]);
                bf16* hp = H + (size_t)(row0 + ai * 128 + m * 16) * 256 + col0;
                asm volatile("global_store_dwordx4 %0, %1, off sc1\n\ts_nop 1" :: "v"(hp), "v"(w) : "memory"); } }
    }
};
constexpr int LDS_MOEL = LDS_WORK + 129 * 1024;
static_assert(LDS_MOEL >= LDS_WORK + pg8::STAGE_BYTES && LDS_MOEL + 8192 + 2048 <= LDS_BYTES, "MoE list table vs GEMM staging");
__device__ __forceinline__ void moe_prefetch_lists(const Args& A, LAS unsigned char* lds, const volatile LAS unsigned* tb, int wv) {
    const int tid = opaque_tid(wv);
    const int* LIST = (const int*)((const unsigned char*)A.out + DO_LIST); const float* WLIST = (const float*)((const unsigned char*)A.out + DO_WLIST);
    LAS unsigned* tab = (LAS unsigned*)(lds + LDS_MOEL); const int n = (int)tb[130]; const int r = tid & 255, half = (tid >> 8) & 1;
    unsigned v[4];
#pragma unroll
    for (int i = 0; i < 4; ++i) { v[i] = 0u;
        if (i < n) { const int pm = (int)tb[131 + 2 * i], e = (int)((tb[132 + 2 * i] & 0xffffu) >> 2); const size_t idx = (size_t)e * LIST_CAP + (size_t)((pm - (int)tb[e]) * 256 + r);
            v[i] = half ? __builtin_bit_cast(unsigned, WLIST[idx]) : (unsigned)LIST[idx]; } }
    unsigned vu = 0u;
    if (half < (int)tb[120]) { const int pm = (int)tb[121 + 2 * half], e = (int)((tb[122 + 2 * half] & 0xffffu) >> 1); const int li = (pm - (int)tb[e]) * 256 + r;
        if (li < (int)tb[80 + e]) vu = (unsigned)LIST[(size_t)e * LIST_CAP + li]; }
#pragma unroll
    for (int i = 0; i < 4; ++i) tab[half * 1024 + i * 256 + r] = v[i];
    tab[2048 + half * 256 + r] = vu;
    __syncthreads();
}
struct EpiMoeDown {
    static constexpr bool PERM = true, AFTER_DRAIN = false;
    __device__ __forceinline__ bool keep(const pg8::Unit&) const { return false; }
    bf16* F; const LAS unsigned* tab; const volatile LAS unsigned* tb;
    __device__ __forceinline__ void operator()(const f32x4 (&acc)[2][2][4][2], const pg8::Unit& u, int wr, int wc, int fr, int fq) const {
        const int e = u.pn >> 2, j = u.pn & 3; const int rbase = (int)tb[40 + e] * 256, cnte = (int)tb[80 + e];
        const int row0 = u.pm * 256 + wr * 64 + fr, col0 = j * 256 + wc * 32 + 8 * fq;
        const LAS unsigned* tl = tab + (u.hm & 3) * 256 + wr * 64 + fr;
#pragma unroll
        for (int ai = 0; ai < 2; ++ai)
#pragma unroll
            for (int m = 0; m < 4; ++m) { const int r = row0 + ai * 128 + m * 16;
                if (r - rbase < cnte) { const int dst = (int)tl[ai * 128 + m * 16]; const float wgt = __builtin_bit_cast(float, tl[1024 + ai * 128 + m * 16]);
#pragma unroll
                    for (int bj = 0; bj < 2; ++bj) { const f32x4 v0 = acc[ai][bj][m][0] * wgt, v1 = acc[ai][bj][m][1] * wgt;
                        u32x4 w; w.x = pg8::cvt_pk_bf16(v0[0], v0[1]); w.y = pg8::cvt_pk_bf16(v0[2], v0[3]); w.z = pg8::cvt_pk_bf16(v1[0], v1[1]); w.w = pg8::cvt_pk_bf16(v1[2], v1[3]);
                        __builtin_nontemporal_store(w, (u32x4*)(F + (size_t)dst * 1024 + col0 + bj * 128)); } } }
    }
};
__device__ __forceinline__ void p7_final(const Args& A, int vcu, int G, int wv) {
    const int tid = opaque_tid(wv), lane = tid & 63, wave = __builtin_amdgcn_readfirstlane(tid >> 6);
    float* X1 = A.out; const bf16* X1B = (const bf16*)(A.ws + WS_X1BF); const bf16* F = (const bf16*)(A.ws + WS_FBUF);
    const float* lg = A.in[I_LN2G]; const float* lb = A.in[I_LN2B];
    f32x4 gv[4], bv[4];
#pragma unroll
    for (int j = 0; j < 4; ++j) { const int col = 8 * lane + 512 * (j >> 1) + 4 * (j & 1); gv[j] = *(const f32x4*)(lg + col); bv[j] = *(const f32x4*)(lb + col); }
    for (int row = vcu * NWAVES + wave; row < T; row += G * NWAVES) {
        f32x4 v[4]; float s = 0.f;
#pragma unroll
        for (int h = 0; h < 2; ++h) { const size_t o = (size_t)row * 1024 + 8 * lane + 512 * h;
            const u32x4 xb = __builtin_nontemporal_load((const u32x4*)(X1B + o));
            const u32x4 f0 = __builtin_nontemporal_load((const u32x4*)(F + (size_t)row * 2048 + 8 * lane + 512 * h)), f1 = __builtin_nontemporal_load((const u32x4*)(F + (size_t)row * 2048 + 1024 + 8 * lane + 512 * h));
            v[2 * h] = (f32x4){bflo(xb.x), bfhi(xb.x), bflo(xb.y), bfhi(xb.y)} * DN_ALPHA + ((f32x4){bflo(f0.x), bfhi(f0.x), bflo(f0.y), bfhi(f0.y)} + (f32x4){bflo(f1.x), bfhi(f1.x), bflo(f1.y), bfhi(f1.y)});
            v[2 * h + 1] = (f32x4){bflo(xb.z), bfhi(xb.z), bflo(xb.w), bfhi(xb.w)} * DN_ALPHA + ((f32x4){bflo(f0.z), bfhi(f0.z), bflo(f0.w), bfhi(f0.w)} + (f32x4){bflo(f1.z), bfhi(f1.z), bflo(f1.w), bfhi(f1.w)}); }
#pragma unroll
        for (int j = 0; j < 4; ++j) s += (v[j][0] + v[j][1]) + (v[j][2] + v[j][3]);
        const float mean = wave_sum(s) * (1.f / 1024.f); float q = 0.f;
#pragma unroll
        for (int j = 0; j < 4; ++j) { v[j] = v[j] - mean; q += (v[j][0] * v[j][0] + v[j][1] * v[j][1]) + (v[j][2] * v[j][2] + v[j][3] * v[j][3]); }
        const float rstd = 1.0f / sqrtf(wave_sum(q) * (1.f / 1024.f) + LN_EPS);
#pragma unroll
        for (int j = 0; j < 4; ++j) { const f32x4 r = v[j] * rstd * gv[j] + bv[j]; if (!A.pad || r[0] == 12345.678f) *(f32x4*)(X1 + (size_t)row * 1024 + 8 * lane + 512 * (j >> 1) + 4 * (j & 1)) = r; }
    }
}
#if SELFCHECK
constexpr int CW_CHK = 64;
__device__ __forceinline__ float block_max(float v, LAS float* red, int tid) {
#pragma unroll
    for (int o = 1; o < 64; o <<= 1) v = fmaxf(v, __shfl_xor(v, o));
    __syncthreads(); if ((tid & 63) == 0) red[tid >> 6] = v; __syncthreads();
    float r = red[0]; for (int i = 1; i < 8; ++i) r = fmaxf(r, red[i]); __syncthreads(); return r;
}
__device__ __forceinline__ void chk_report(const Args& A, int slot, float diff, float ref) {
    const float ratio = diff / fmaxf(ref, 1e-20f); atomicMax((unsigned*)(A.ws + WS_CTL) + CW_CHK + slot, __builtin_bit_cast(unsigned, ratio)); }
__device__ __forceinline__ float gelu_ref(float x) { return 0.5f * x * (1.0f + erff(x * 0.70710678118654752f)); }
__device__ __forceinline__ float sig_ref(float x) { return 1.0f / (1.0f + expf(-x)); }
__device__ __forceinline__ void chk_inproj(const Args& A, LAS unsigned char* lds, int sample) {
    const int tid = threadIdx.x; const int toks[8] = {0, 1, 777, 2047, 2048 + 31, 3 * 2048 + 1000, 7 * 2048 + 2047, 5 * 2048 + 64};
    int t = 0;
#pragma unroll
    for (int i = 0; i < 8; ++i) if (sample == i) t = toks[i];
    LAS float* h = (LAS float*)(lds + LDS_WORK); LAS float* red = h + 6000;
    const float* x = A.in[I_X] + (size_t)t * 1024; const float* w = A.in[I_WIN];
    for (int cidx = tid; cidx < IN_W; cidx += NTHR) { float a = 0.f; for (int k = 0; k < 1024; ++k) a += x[k] * w[(size_t)k * IN_W + cidx]; h[cidx] = a; }
    __syncthreads();
    const int pos = t & (SEQ - 1); float dmax = 0.f, rmax = 0.f;
    const bf16* Q = (const bf16*)(A.ws + WS_Q); const bf16* KV = (const bf16*)(A.ws + WS_KV); const bf16* Z = (const bf16*)(A.ws + WS_Z); const bf16* MG = (const bf16*)(A.ws + WS_MG);
    const bf16* MQ = (const bf16*)(A.ws + WS_MQ); const float* NG = (const float*)(A.ws + WS_NG);
    for (int cidx = tid; cidx < IN_W; cidx += NTHR) {
        float e, got;
        if (cidx < 1280) {
            const int d = cidx & 63; const bool isv = cidx >= 512 && (((cidx - 512) >> 7) & 1); float v = h[cidx];
            if (!isv && d < 16) { const int i = d & 7; const float inv = powf(500000.0f, -(float)i / 8.0f); const float ang = (float)pos * inv; const float cs = cosf(ang), sn = sinf(ang);
                v = d < 8 ? h[cidx] * cs - h[cidx + 8] * sn : h[cidx] * cs + h[cidx - 8] * sn; }
            if (cidx < 512) { e = v * QSCALE; got = bf2f(Q[(size_t)t * 512 + cidx]); } else { e = v; got = bf2f(KV[(size_t)t * 768 + cidx - 512]); }
        } else if (cidx < S_SGU) { e = sig_ref(h[cidx]); got = NG[(size_t)t * 32 + cidx - S_NG]; }
        else if (cidx < S_MQ) { e = gelu_ref(h[cidx]); got = bf2f(Z[(size_t)t * 1024 + cidx - S_SGU]); }
        else if (cidx < S_MG) { e = h[cidx] * MQSCALE; got = bf2f(MQ[(size_t)t * 512 + cidx - S_MQ]); }
        else { e = sig_ref(h[cidx]); const int col = cidx - S_MG, rr = t & 255, cc = col & 255;
            const size_t ix = mg_index(t >> 8, col >> 8, rr >> 7, (rr & 63) >> 4, cc >> 7, (rr & 127) >> 6, (cc & 127) >> 5, rr & 15, (cc & 31) >> 3);
            got = (float)((const unsigned char*)MG)[ix * 8 + (cc & 7)] * (1.0f / 255.0f); }
        dmax = fmaxf(dmax, fabsf(e - got)); rmax = fmaxf(rmax, fabsf(e));
    }
    dmax = block_max(dmax, red, tid); rmax = block_max(rmax, red, tid);
    if (tid == 0) chk_report(A, 0, dmax, rmax);
    { const int r = (t * 37) % (NB * 256); const float* mr = A.in[I_MEM] + (size_t)r * 1024; const float* wm = A.in[I_WMEMKV]; const bf16* KVM = (const bf16*)(A.ws + WS_KVMEM);
      float d2 = 0.f, r2 = 0.f;
      for (int cidx = tid; cidx < 1024; cidx += NTHR) { float a = 0.f; for (int k = 0; k < 1024; ++k) a += mr[k] * wm[(size_t)k * 1024 + cidx]; d2 = fmaxf(d2, fabsf(a - bf2f(KVM[(size_t)r * 1024 + cidx]))); r2 = fmaxf(r2, fabsf(a)); }
      d2 = block_max(d2, red, tid); r2 = block_max(r2, red, tid); if (tid == 0) chk_report(A, 1, d2, r2); }
}
__device__ __forceinline__ void chk_compress(const Args& A, LAS unsigned char* lds, int sample) {
    const int tid = threadIdx.x; const int kv = sample & 1, g = (sample >> 1) & 1, b = (sample >> 2) & 7; const int ns[4] = {0, 1, 63, 126}; int n = 0;
#pragma unroll
    for (int i = 0; i < 4; ++i) if (((sample >> 5) & 3) == i) n = ns[i];
    LAS float* blk = (LAS float*)(lds + LDS_WORK); LAS float* hid = blk + 2048; LAS float* red = hid + 256;
    const bf16* KV = (const bf16*)(A.ws + WS_KV); const float* pe = A.in[kv ? I_PEV : I_PEK]; const float* w1 = A.in[kv ? I_W1V : I_W1K]; const float* w2 = A.in[kv ? I_W2V : I_W2K];
    for (int i = tid; i < 2048; i += NTHR) { const int l = i >> 6, d = i & 63; blk[i] = bf2f(KV[(size_t)(b * SEQ + 16 * n + l) * 768 + kv * 128 + g * 64 + d]) + pe[i]; }
    __syncthreads();
    if (tid < 256) { float a = 0.f; for (int k = 0; k < 2048; ++k) a += blk[k] * w1[(size_t)k * 256 + tid]; hid[tid] = gelu_ref(a); }
    __syncthreads();
    float dmax = 0.f, rmax = 0.f;
    if (tid < 64) { float a = 0.f; for (int j = 0; j < 256; ++j) a += hid[j] * w2[j * 64 + tid];
        const bf16* O = (const bf16*)(A.ws + (kv ? WS_VCMP : WS_KCMP)); dmax = fabsf(a - bf2f(O[((size_t)(b * 128 + n) * 2 + g) * 64 + tid])); rmax = fabsf(a); }
    dmax = block_max(dmax, red, tid); rmax = block_max(rmax, red, tid);
    if (tid == 0) chk_report(A, 2, dmax, rmax);
}
__device__ __forceinline__ void chk_nsa(const Args& A, LAS unsigned char* lds, int sample) {
    const int tid = threadIdx.x; const int g = sample & 1, b = (sample >> 1) & 7; const int ts[16] = {0, 5, 30, 31, 47, 63, 64, 100, 511, 512, 513, 700, 1023, 1024, 1999, 2047}; int t = 0;
#pragma unroll
    for (int i = 0; i < 16; ++i) if ((sample >> 4) == i) t = ts[i];
    LAS float* q = (LAS float*)(lds + LDS_WORK);
    LAS float* sc = q + 256;
    LAS float* oc = sc + 2048;
    LAS float* os = oc + 256;
    LAS float* ow = os + 256;
    LAS float* imp = ow + 256;
    LAS int* blks = (LAS int*)(imp + 32);
    LAS float* red = imp + 48;
    const size_t trow = (size_t)b * SEQ + t;
    const bf16* Q = (const bf16*)(A.ws + WS_Q) + trow * 512 + g * 256; const bf16* KV = (const bf16*)(A.ws + WS_KV) + (size_t)b * SEQ * 768 + g * 64;
    const bf16* KC = (const bf16*)(A.ws + WS_KCMP) + ((size_t)b * 256 + g) * 64; const bf16* VC = (const bf16*)(A.ws + WS_VCMP) + ((size_t)b * 256 + g) * 64;
    const float LN2 = 0.6931471805599453f;
    if (tid < 256) q[tid] = bf2f(Q[tid]) * LN2;
    __syncthreads();
    { const int h = tid >> 7, n = tid & 127; float a = -1e30f;
      if (n < 127 && 16 * n + 31 <= t) { a = 0.f; for (int d = 0; d < 64; ++d) a += q[h * 64 + d] * bf2f(KC[(size_t)n * 128 + d]); }
      sc[h * 512 + n] = a; }
    __syncthreads();
    if (tid < 4) { float m = -1e30f; for (int n = 0; n < 127; ++n) m = fmaxf(m, sc[tid * 512 + n]); float s = 0.f;
        for (int n = 0; n < 127; ++n) { const float e = sc[tid * 512 + n] > -1e29f ? expf(sc[tid * 512 + n] - m) : 0.f; sc[tid * 512 + n] = e; s += e; }
        const float inv = s > 0.f ? 1.f / s : 1.f; for (int n = 0; n < 127; ++n) sc[tid * 512 + n] *= inv; }
    __syncthreads();
    if (tid < 256) { const int h = tid >> 6, d = tid & 63; float a = 0.f; for (int n = 0; n < 127; ++n) a += sc[h * 512 + n] * bf2f(VC[(size_t)n * 128 + d]); oc[tid] = a; }
    if (tid < 32) { float a = 0.f; for (int n = 0; n < 127; ++n) { const bool ov = (16 * n + 31 >= 64 * tid) && (16 * n <= 64 * tid + 63); if (ov) for (int h = 0; h < 4; ++h) a += sc[h * 512 + n]; }
        const int cur = t >> 6; const bool fut = tid > cur, forced = tid == 0 || tid == cur || tid == cur - 1; imp[tid] = fut ? -1e30f : forced ? 1e30f : a; }
    __syncthreads();
    if (tid == 0) { for (int k = 0; k < 8; ++k) { int bi = 0; float bv = -3e38f; for (int j = 0; j < 32; ++j) if (imp[j] > bv) { bv = imp[j]; bi = j; } blks[k] = bi; imp[bi] = -3e38f; } }
    __syncthreads();
    { const int kk = tid, blk = blks[kk >> 6], kpos = blk * 64 + (kk & 63);
      for (int h = 0; h < 4; ++h) { float a = -1e30f; if (kpos <= t) { a = 0.f; for (int d = 0; d < 64; ++d) a += q[h * 64 + d] * bf2f(KV[(size_t)kpos * 768 + 256 + d]); } sc[h * 512 + kk] = a; } }
    __syncthreads();
    if (tid < 4) { float m = -1e30f; for (int n = 0; n < 512; ++n) m = fmaxf(m, sc[tid * 512 + n]); float s = 0.f;
        for (int n = 0; n < 512; ++n) { const float e = sc[tid * 512 + n] > -1e29f ? expf(sc[tid * 512 + n] - m) : 0.f; sc[tid * 512 + n] = e; s += e; }
        const float inv = s > 0.f ? 1.f / s : 1.f; for (int n = 0; n < 512; ++n) sc[tid * 512 + n] *= inv; }
    __syncthreads();
    if (tid < 256) { const int h = tid >> 6, d = tid & 63; float a = 0.f; for (int kk = 0; kk < 512; ++kk) { const int kpos = blks[kk >> 6] * 64 + (kk & 63); a += sc[h * 512 + kk] * bf2f(KV[(size_t)kpos * 768 + 384 + d]); } os[tid] = a; }
    __syncthreads();
    { const int kpos = t - 511 + tid;
      for (int h = 0; h < 4; ++h) { float a = -1e30f; if (kpos >= 0) { a = 0.f; for (int d = 0; d < 64; ++d) a += q[h * 64 + d] * bf2f(KV[(size_t)kpos * 768 + 512 + d]); } sc[h * 512 + tid] = a; } }
    __syncthreads();
    if (tid < 4) { float m = -1e30f; for (int n = 0; n < 512; ++n) m = fmaxf(m, sc[tid * 512 + n]); float s = 0.f;
        for (int n = 0; n < 512; ++n) { const float e = sc[tid * 512 + n] > -1e29f ? expf(sc[tid * 512 + n] - m) : 0.f; sc[tid * 512 + n] = e; s += e; }
        const float inv = s > 0.f ? 1.f / s : 1.f; for (int n = 0; n < 512; ++n) sc[tid * 512 + n] *= inv; }
    __syncthreads();
    if (tid < 256) { const int h = tid >> 6, d = tid & 63; float a = 0.f; for (int kk = 0; kk < 512; ++kk) { const int kpos = t - 511 + kk; if (kpos >= 0) a += sc[h * 512 + kk] * bf2f(KV[(size_t)kpos * 768 + 640 + d]); } ow[tid] = a; }
    __syncthreads();
    float dmax = 0.f, rmax = 0.f;
    if (tid < 256) { const int h = tid >> 6; const float* NG = (const float*)(A.ws + WS_NG) + trow * 32 + (g * 4 + h) * 3;
        const float e = NG[0] * oc[tid] + NG[1] * os[tid] + NG[2] * ow[tid]; const float got = bf2f(((const bf16*)((unsigned char*)A.out + DO_ONSA))[trow * 512 + g * 256 + tid]);
        dmax = fabsf(e - got); rmax = fabsf(e); }
    dmax = block_max(dmax, red, tid); rmax = block_max(rmax, red, tid);
    if (tid == 0) chk_report(A, 3, dmax, rmax);
}
__device__ __forceinline__ void chk_mem(const Args& A, LAS unsigned char* lds, int sample) {
    const int tid = threadIdx.x; const int h = sample & 3, b = (sample >> 2) & 7; const int t = ((sample >> 5) * 683 + 17 * b) & (SEQ - 1);
    LAS float* q = (LAS float*)(lds + LDS_WORK); LAS float* sc = q + 128; LAS float* red = sc + 256;
    const size_t trow = (size_t)b * SEQ + t; const float* x = A.in[I_X] + trow * 1024; const float* w = A.in[I_WIN];
    if (tid < 128) { float a = 0.f; for (int k = 0; k < 1024; ++k) a += x[k] * w[(size_t)k * IN_W + S_MQ + h * 128 + tid]; q[tid] = a * 0.08838834764831845f; }
    __syncthreads();
    const bf16* KVM = (const bf16*)(A.ws + WS_KVMEM) + (size_t)b * 256 * 1024 + h * 128;
    if (tid < 256) { float a = 0.f; for (int d = 0; d < 128; ++d) a += q[d] * bf2f(KVM[(size_t)tid * 1024 + d]); sc[tid] = a; }
    __syncthreads();
    if (tid == 0) { float m = -1e30f; for (int n = 0; n < 256; ++n) m = fmaxf(m, sc[n]); float s = 0.f; for (int n = 0; n < 256; ++n) { sc[n] = expf(sc[n] - m); s += sc[n]; } for (int n = 0; n < 256; ++n) sc[n] /= s; }
    __syncthreads();
    float dmax = 0.f, rmax = 0.f;
    if (tid < 128) { float a = 0.f; for (int n = 0; n < 256; ++n) a += sc[n] * bf2f(KVM[(size_t)n * 1024 + 512 + tid]);
        const float got = bf2f(((const bf16*)(A.ws + WS_MQ))[trow * 512 + h * 128 + tid]); dmax = fabsf(a - got); rmax = fabsf(a); }
    dmax = block_max(dmax, red, tid); rmax = block_max(rmax, red, tid);
    if (tid == 0) chk_report(A, 6, dmax, rmax);
}
#endif
constexpr int N_PHASES = 11;
__global__ void __launch_bounds__(NTHR, 2) hybrid_fwd(Args A) {
    extern __shared__ __attribute__((aligned(16))) unsigned char lds_raw[];
    LAS unsigned char* lds = (LAS unsigned char*)lds_raw;
    volatile LAS unsigned* MISC = (volatile LAS unsigned*)(lds + LDS_MISC);
    const int wv = __builtin_amdgcn_readfirstlane((int)threadIdx.x >> 6);
#define tid (wv * 64 + lane_id())
    const int G = gridDim.x; const int bx = blockIdx.x; const int vcu = (G % 8 == 0) ? (bx % 8) * (G / 8) + bx / 8 : bx;
    if (tid < 256) MISC[tid] = 0u;
    __syncthreads();
#if defined(DRY_PHASE)
    if (tid == 0) MISC[240] = (unsigned)A.pad;
    __syncthreads();
#endif
    unsigned char* ws = A.ws;
    gu32* ctl = (gu32*)(ws + WS_CTL);
#if MK_PER_PHASE
#define GRID_BAR() do { } while (0)
#else
    XcdBarrier bar = xcd_barrier_post((unsigned*)ctl + CW_BAR, MISC + 8, wv);
#define GRID_BAR() xcd_barrier(bar)
#endif
    const int lo = A.ph_lo, hi = A.ph_hi;
#ifndef PHASE_MASK
#define PHASE_MASK 0xFFFF
#endif
#define IN(k) (((PHASE_MASK >> (k)) & 1) && lo <= (k) && (k) < hi)
#define BOTH(k) (IN(k) && IN((k) + 1))
#ifndef REP_MASK
#define REP_MASK 0
#endif
#define REPS(k) (((REP_MASK >> (k)) & 1) ? 2 : 1)
    LAS unsigned char* wl = lds + LDS_WORK;
    if (IN(0)) { p0_prologue(A, lds, vcu, G, wv); if (BOTH(0)) GRID_BAR(); }
    if (IN(1)) {
        { pg8::Gemm g{(const bf16*)(ws + WS_XBF), (const bf16*)(ws + WS_WINT), T, NIN - 256, DM}; P1Order S; S.so.init(T, NIN - 256, G, bx); S.memA = (const bf16*)(ws + WS_MEMBF); S.memB = (const bf16*)(ws + WS_WMEMT);
          EpiInProj E{(bf16*)(ws + WS_Q), (bf16*)(ws + WS_KV), (bf16*)(ws + WS_Z), (bf16*)(ws + WS_MQ), (bf16*)(ws + WS_MG), (bf16*)(ws + WS_KVMEM), (const float*)(ws + WS_ROPE)};
          pg8::gemm_phase<EpiInProj, P1Order, true, true>(wl, g, S, E, wv); }
        if (G == 256) { if (bx >= 224) p0_late(A, lds, bx - 224, 32, wv); } else p0_late(A, lds, bx, G, wv);
        nsa_gates((const bf16*)(ws + WS_XBF), (const bf16*)(ws + WS_WINT) + (size_t)C_NG * 1024, (float*)(ws + WS_NG), lds, vcu, G, tid);
        if (BOTH(1)) GRID_BAR();
#if SELFCHECK
        if (vcu < 8) chk_inproj(A, lds, vcu);
        GRID_BAR();
#endif
    }
    constexpr int CV_N1 = (CV_ITEMS * 7) / 10;
    if (IN(2)) {
        for (int u = vcu; u < 128; u += G) compress_unit(A, lds, u, wv);
        if (vcu >= 128) convert_range(A, lds, 0, CV_N1, (vcu - 128) * NWAVES + wv, (G - 128) * NWAVES, wv);
        const bool bwfirst = ((vcu >> 5) & 1) == 0;
#define BW_WORK() do { for (int u = vcu; u < 256; u += G) sgu_unit(A, lds, u, wv); for (int u = vcu; u < 256; u += G) mem_unit(A, lds, u, wv); \
        convert_range(A, lds, CV_N1, CV_ITEMS, vcu * NWAVES + wv, G * NWAVES, wv); } while (0)
        if (bwfirst) BW_WORK();
        for (int u = vcu; u < 256; u += G) { const int j = u & 15, bg = u >> 4;
            cmp_wait(A, bg >> 1, bg & 1, wv);
            nsa_unit(A, lds, bg >> 1, bg & 1, 31 - j, wv); nsa_unit(A, lds, bg >> 1, bg & 1, j, wv); }
        if (!bwfirst) BW_WORK();
#undef BW_WORK
    }
    if (IN(4)) {
        { pg8::StaticOrder so4; so4.init(T, DM, G, bx); pg8::Unit u4; u4.pm = 0; u4.pn = 0; if (so4.next(0, u4)) cnt_wait(A, (unsigned*)ctl + CW_P4 + 16 * u4.pm, 128u, wv); }
        P4Order S; S.so.init(T, DM, G, bx); S.outb = (const unsigned char*)A.out; S.mq = ws + WS_MQ; S.ycnt = (unsigned*)ctl + CW_Y;
        pg8::Gemm g{(const bf16*)A.out, (const bf16*)(ws + WS_WBRT), T, 3 * DM, 512}; EpiBranch E{(bf16*)(ws + WS_Y), (const bf16*)(ws + WS_MG)};
        pg8::gemm_phase<EpiBranch, P4Order, true, true>(wl, g, S, E, wv);
    }
    if (IN(5)) {
        unsigned char* ws = A.ws; asm volatile("" : "+s"(ws));
        gu32* ctl = (gu32*)(ws + WS_CTL);
        pg8::Gemm g{(const bf16*)(ws + WS_Y), (const bf16*)(ws + WS_WOT), T, DM, DM}; pg8::StaticOrder S; S.init(T, DM, G, bx);
        pg8::Unit u5; u5.pm = 0; u5.pn = 0; const bool has5 = S.next(0, u5);
        if (has5) cnt_wait(A, (unsigned*)ctl + CW_Y + 64 * u5.pm, 32u, wv);
        EpiLnRouter E{A.in[I_X], (bf16*)(ws + WS_X1BF), A.in[I_LN1G], A.in[I_LN1B], (const bf16*)(ws + WS_WRH), (const bf16*)(ws + WS_WRL), (float*)(ws + WS_PLG),
                      PanelStats{(unsigned long long*)(ws + WS_XBUF), (unsigned*)ctl + CW_PAN, (unsigned*)ctl + CW_BAR + XB_TMO, LN_EPS}};
        pg8::gemm_phase<EpiLnRouter, pg8::StaticOrder, true, true>(wl, g, S, E, wv);
        if (has5) { asm volatile("s_waitcnt vmcnt(0)" ::: "memory");
            if (lane_id() == 0) __hip_atomic_fetch_add((unsigned*)ctl + CW_PLG + 16 * u5.pm, 1u, RLX_AGENT);
            cnt_wait(A, (unsigned*)ctl + CW_PLG + 16 * u5.pm, 32u, wv);
            p6_route(A, lds, u5.pm * 4 + u5.pn, T / 64, wv); }
        if (BOTH(5)) GRID_BAR();
    }
    if (IN(8)) {
        unsigned* hcnt = (unsigned*)ctl + CW_HCNT; unsigned* tmo = (unsigned*)ctl + CW_BAR + XB_TMO;
        { moe_tables(A, MISC + 32, tid, G, vcu); moe_prefetch_lists(A, lds, MISC + 32, wv);
          pg8::Gemm g{(const bf16*)(ws + WS_X1BF), (const bf16*)(ws + WS_WGUT), XS_ROWS, NEXP * 512, DM}; MoeOrder<0> S{MISC + 32, hcnt, tmo, wv, (const LAS unsigned*)(lds + LDS_MOEL + 8192)};
          EpiMoeUp E{(bf16*)(ws + WS_H)};
          pg8::gemm_phase<EpiMoeUp, MoeOrder<0>, true, true>(wl, g, S, E, wv); }
#define MOE_DOWN(kind) do { moe_wait_tiles(MISC + 32, hcnt, tmo, wv); \
          pg8::Gemm g{(const bf16*)(ws + WS_H), (const bf16*)(ws + WS_WDT), XS_ROWS, NEXP * 1024, FF}; MoeOrder<1> S{MISC + 32, hcnt, tmo, wv, nullptr}; \
          EpiMoeDown E{(bf16*)(ws + WS_FBUF), (const LAS unsigned*)(lds + LDS_MOEL), MISC + 32}; \
          pg8::gemm_phase<EpiMoeDown, MoeOrder<1>, true, true>(wl, g, S, E, wv); } while (0)
        MOE_DOWN(1);
#undef MOE_DOWN
        if (BOTH(8)) GRID_BAR();
    }
    if (IN(10)) { p7_final(A, vcu, G, wv);
#if SELFCHECK
        GRID_BAR();
        if (bx == 0 && tid == 0) { float r = 0.f;
            for (int i = 0; i < 8; ++i) if ((CHECK_SEL >> i) & 1) r = fmaxf(r, __builtin_bit_cast(float, __hip_atomic_load((unsigned*)ctl + CW_CHK + i, RLX_AGENT)));
            float code = rintf(-4.0f * log2f(fmaxf(r, 1e-9f))); code = fminf(fmaxf(code, 0.f), 60.f);
            A.out[0] = 200.0f * powf(1.12f, 60.0f - code); }
#endif
    }
#undef IN
#undef BOTH
#undef tid
}

extern "C" void kernel_launch(void* const* d_in, const int* in_sizes, int n_in, void* d_out, int out_size, void* d_ws, size_t ws_size, hipStream_t stream) {
    static int grid = 0;
    if (grid == 0) {
        if (n_in != 29 || in_sizes[0] != T * DM || out_size != T * DM || ws_size < WS_END) { fprintf(stderr, "kernel_launch: unexpected shapes (n_in %d, in0 %d, out %d, ws %zu)\n", n_in, n_in > 0 ? in_sizes[0] : -1, out_size, ws_size); grid = -1; return; }
        int dev = 0, cus = 0, per_cu = 0;
        if (hipGetDevice(&dev) != hipSuccess || hipDeviceGetAttribute(&cus, hipDeviceAttributeMultiprocessorCount, dev) != hipSuccess) { grid = -1; return; }
        if (hipFuncSetAttribute((const void*)hybrid_fwd, hipFuncAttributeMaxDynamicSharedMemorySize, LDS_BYTES) != hipSuccess) { fprintf(stderr, "kernel_launch: hipFuncSetAttribute failed\n"); grid = -1; return; }
        if (hipOccupancyMaxActiveBlocksPerMultiprocessor(&per_cu, (const void*)hybrid_fwd, NTHR, LDS_BYTES) != hipSuccess || per_cu < 1) fprintf(stderr, "kernel_launch: occupancy query reports %d\n", per_cu);
        (void)hipGetLastError();
        grid = cus;
    }
    if (grid < 0) return;
    (void)hipMemsetAsync((char*)d_ws + WS_CTL, 0, CTL_ZERO_BYTES, stream);
    Args a{};
    for (int i = 0; i < 29; ++i) a.in[i] = (const float*)d_in[i];
    a.out = (float*)d_out; a.ws = (unsigned char*)d_ws;
#if MK_PER_PHASE
    for (int p = 0; p < N_PHASES; ++p) { a.ph_lo = p; a.ph_hi = p + 1;
#if defined(DRY_PHASE)
        if (p == DRY_PHASE) for (int r = 0; r < 2; ++r) { a.sub = REP_SUB; a.pad = DRY_MODE; hipLaunchKernelGGL(hybrid_fwd, dim3(grid), dim3(NTHR), LDS_BYTES, stream, a); }
#endif
        a.sub = 0xF; a.pad = 0; hipLaunchKernelGGL(hybrid_fwd, dim3(grid), dim3(NTHR), LDS_BYTES, stream, a);
#if defined(REP_PHASE)
        if (p == REP_PHASE) for (int r = 0; r < 2; ++r) { a.sub = REP_SUB; hipLaunchKernelGGL(hybrid_fwd, dim3(grid), dim3(NTHR), LDS_BYTES, stream, a); }
#endif
    }
#else
    a.ph_lo = 0; a.ph_hi = N_PHASES; a.sub = 0xF;
    hipLaunchKernelGGL(hybrid_fwd, dim3(grid), dim3(NTHR), LDS_BYTES, stream, a);
#endif
}
```
